# Optimizing an MI355X kernel written in HIP

```python
import math
import jax, jax.numpy as jnp
from jax import lax
import numpy as np

D_MODEL = 1024
BATCH = 8
SEQ = 8192
DEPTH = 4

A_HEADS = 8
A_KV_HEADS = 2
A_HEAD_DIM = 64
WINDOW = 128
BLOCK = 128
B_HEADS = 8
Q_LORA = 384
KV_LORA = 256
NOPE_DIM = 64
ROPE_DIM = 32
V_DIM = 64
ROPE_THETA = 10000.0
N_BUCKETS = 32
MAX_DISTANCE = 128
D_FF = 4 * D_MODEL
EPS = 1e-5

A_Q_W = A_HEADS * A_HEAD_DIM
A_KV_W = A_KV_HEADS * A_HEAD_DIM
B_QK_DIM = NOPE_DIM + ROPE_DIM
A_OUT = A_HEADS * A_HEAD_DIM
B_OUT = B_HEADS * V_DIM
IN_SPLITS = (A_Q_W, A_KV_W, A_KV_W, Q_LORA, KV_LORA, ROPE_DIM, D_MODEL, D_MODEL)
D_IN = A_Q_W + 2 * A_KV_W + Q_LORA + KV_LORA + ROPE_DIM + 2 * D_MODEL

kernel_name = "hybrid_swa_sink_mla_gated_trunk"


def rmsnorm(x, g):
    xf = x.astype(jnp.float32)
    y = xf * lax.rsqrt(jnp.mean(xf * xf, axis=-1, keepdims=True) + EPS)
    return (y * g.astype(jnp.float32)).astype(x.dtype)


def rope(t, positions):
    half = ROPE_DIM // 2
    inv_freq = ROPE_THETA ** (-jnp.arange(half, dtype=jnp.float32) / half)
    ang = positions.astype(jnp.float32)[..., None] * inv_freq
    ang = ang.reshape(ang.shape[:2] + (1,) * (t.ndim - 3) + (half,))
    cos, sin = jnp.cos(ang), jnp.sin(ang)
    tf = t.astype(jnp.float32)
    t1, t2 = tf[..., :half], tf[..., half:]
    return jnp.concatenate([t1 * cos - t2 * sin, t2 * cos + t1 * sin], axis=-1).astype(t.dtype)


def t5_bucket(dist):
    max_exact = N_BUCKETS // 2
    n = jnp.maximum(dist, 0)
    nf = jnp.maximum(n, 1).astype(jnp.float32)
    large = max_exact + (jnp.log(nf / max_exact) / math.log(MAX_DISTANCE / max_exact)
                         * (N_BUCKETS - max_exact)).astype(jnp.int32)
    large = jnp.minimum(large, N_BUCKETS - 1)
    return jnp.where(n < max_exact, n, large)


def swa_sink_attention(q, k, v, sinks, rel_table):
    B, S = q.shape[:2]
    nb = S // BLOCK
    G = A_HEADS // A_KV_HEADS
    qb = q.reshape(B, nb, BLOCK, A_KV_HEADS, G, A_HEAD_DIM)

    def with_prev(t):
        tb = t.reshape(B, nb, BLOCK, A_KV_HEADS, A_HEAD_DIM)
        prev = jnp.pad(tb[:, :-1], ((0, 0), (1, 0), (0, 0), (0, 0), (0, 0)))
        return jnp.concatenate([prev, tb], axis=2)

    kb, vb = with_prev(k), with_prev(v)
    qi = jnp.arange(BLOCK)[:, None]
    kj = jnp.arange(2 * BLOCK)[None, :]
    dist = BLOCK + qi - kj
    in_win = (dist >= 0) & (dist < WINDOW)
    blk = jnp.arange(nb)[:, None, None]
    valid = in_win[None] & ((blk > 0) | (kj >= BLOCK)[None])

    bias = rel_table[t5_bucket(dist)]
    bias = bias.transpose(2, 0, 1).reshape(A_KV_HEADS, G, BLOCK, 2 * BLOCK).astype(jnp.float32)

    scale = 1.0 / math.sqrt(A_HEAD_DIM)
    s = jnp.einsum('bnqhgd,bnkhd->bnhgqk', qb, kb).astype(jnp.float32) * scale + bias
    s = jnp.where(valid[None, :, None, None], s, -jnp.inf)
    sink = sinks.astype(jnp.float32).reshape(A_KV_HEADS, G)[None, None, :, :, None, None]
    m = jnp.maximum(jnp.max(s, axis=-1, keepdims=True), sink)
    p = jnp.exp(s - m)
    denom = jnp.sum(p, axis=-1, keepdims=True) + jnp.exp(sink - m)
    p = (p / denom).astype(v.dtype)
    o = jnp.einsum('bnhgqk,bnkhd->bnqhgd', p, vb)
    return o.reshape(B, S, A_OUT)


def mla_attention(c_q, c_kv, k_rope, positions, q_norm, kv_norm, w_uq, w_ukv):
    B, S = c_q.shape[:2]
    q = (rmsnorm(c_q, q_norm) @ w_uq).reshape(B, S, B_HEADS, B_QK_DIM)
    q = jnp.concatenate([q[..., :NOPE_DIM], rope(q[..., NOPE_DIM:], positions)], axis=-1)
    kv = (rmsnorm(c_kv, kv_norm) @ w_ukv).reshape(B, S, B_HEADS, NOPE_DIM + V_DIM)
    k_nope, v = kv[..., :NOPE_DIM], kv[..., NOPE_DIM:]
    k_r = rope(k_rope, positions)
    k = jnp.concatenate([k_nope, jnp.broadcast_to(k_r[:, :, None, :], (B, S, B_HEADS, ROPE_DIM))], axis=-1)

    nb = S // BLOCK
    qb = q.reshape(B, nb, BLOCK, B_HEADS, B_QK_DIM).transpose(1, 0, 2, 3, 4)
    kpos = jnp.arange(S)
    scale = 1.0 / math.sqrt(B_QK_DIM)

    def attend(args):
        qblk, n = args
        s = jnp.einsum('bqhd,bkhd->bhqk', qblk, k).astype(jnp.float32) * scale
        qpos = n * BLOCK + jnp.arange(BLOCK)
        s = jnp.where(kpos[None, :] <= qpos[:, None], s, -jnp.inf)
        p = jax.nn.softmax(s, axis=-1).astype(v.dtype)
        return jnp.einsum('bhqk,bkhd->bqhd', p, v)

    o = lax.map(attend, (qb, jnp.arange(nb)))
    return o.transpose(1, 0, 2, 3, 4).reshape(B, S, B_OUT)


def setup_inputs(seed: int = 0) -> dict:
    key = jax.random.key(seed)
    ks = jax.random.split(key, 20)
    f32 = jnp.float32

    def nrm(k, shape, fan_in):
        return jax.random.normal(k, shape, f32) * (fan_in ** -0.5)

    def gain(k, shape):
        return 1.0 + 0.02 * jax.random.normal(k, shape, f32)

    x = jax.random.normal(ks[0], (BATCH, SEQ, D_MODEL), f32)
    offset = jax.random.randint(ks[1], (BATCH, 1), 0, 4096, dtype=jnp.int32)
    positions = (offset + jnp.arange(SEQ, dtype=jnp.int32)[None, :]).astype(jnp.int32)
    return {
        "x": x,
        "positions": positions,
        "rel_bias_table": 0.5 * jax.random.normal(ks[2], (N_BUCKETS, A_HEADS), f32),
        "norm_mix": gain(ks[3], (DEPTH, D_MODEL)),
        "w_in": nrm(ks[4], (DEPTH, D_MODEL, D_IN), D_MODEL),
        "attn_sinks": 0.5 * jax.random.normal(ks[5], (DEPTH, A_HEADS), f32),
        "q_norm": gain(ks[6], (DEPTH, Q_LORA)),
        "kv_norm": gain(ks[7], (DEPTH, KV_LORA)),
        "w_uq": nrm(ks[8], (DEPTH, Q_LORA, B_HEADS * B_QK_DIM), Q_LORA),
        "w_ukv": nrm(ks[9], (DEPTH, KV_LORA, B_HEADS * (NOPE_DIM + V_DIM)), KV_LORA),
        "w_branch_a": nrm(ks[10], (DEPTH, A_OUT, D_MODEL), A_OUT),
        "w_branch_b": nrm(ks[11], (DEPTH, B_OUT, D_MODEL), B_OUT),
        "w_out": nrm(ks[12], (DEPTH, D_MODEL, D_MODEL), D_MODEL),
        "norm_mlp": gain(ks[13], (DEPTH, D_MODEL)),
        "w_ff1": nrm(ks[14], (DEPTH, D_MODEL, D_FF), D_MODEL),
        "w_ff2": nrm(ks[15], (DEPTH, D_FF, D_MODEL), D_FF),
        "norm_final": gain(ks[16], (D_MODEL,)),
    }


def reference(x, positions, rel_bias_table, norm_mix, w_in, attn_sinks, q_norm, kv_norm,
              w_uq, w_ukv, w_branch_a, w_branch_b, w_out, norm_mlp, w_ff1, w_ff2, norm_final):
    split_at = [int(v) for v in np.cumsum(IN_SPLITS)[:-1]]
    for l in range(DEPTH):
        h = rmsnorm(x, norm_mix[l])
        z = h @ w_in[l]
        q_a, k_a, v_a, c_q, c_kv, k_rope, g_a, g_b = jnp.split(z, split_at, axis=-1)
        y_a = swa_sink_attention(q_a, k_a, v_a, attn_sinks[l], rel_bias_table) @ w_branch_a[l]
        y_b = mla_attention(c_q, c_kv, k_rope, positions, q_norm[l], kv_norm[l],
                            w_uq[l], w_ukv[l]) @ w_branch_b[l]
        merged = jax.nn.sigmoid(g_a) * y_a + jax.nn.sigmoid(g_b) * y_b
        x = x + merged @ w_out[l]
        h = rmsnorm(x, norm_mlp[l])
        x = x + jnp.square(jax.nn.relu(h @ w_ff1[l])) @ w_ff2[l]
    return rmsnorm(x, norm_final)
```

```cpp
#include <hip/hip_runtime.h>
#include <hip/hip_cooperative_groups.h>
#include <cstdio>
#include <cstdint>
namespace cg = cooperative_groups;
__device__ __forceinline__ int hw_lane_id() { return (int)__builtin_amdgcn_mbcnt_hi(~0u, __builtin_amdgcn_mbcnt_lo(~0u, 0u)); }

constexpr int DM = 1024, BATCH = 8, SEQ = 8192, DEPTH = 4, MTOK = BATCH * SEQ;
constexpr int D_IN = 3488, N1 = 1536, NGATE = 2048, QL = 384, KVL = 256, NQB = 768, NKVB = 1024, DFF = 4096;
constexpr float EPS = 1e-5f;
constexpr float LOG2E = 1.4426950408889634f;
constexpr float QA_SCALE = 0.125f * LOG2E;
constexpr float QB_SCALE = 0.10206207261596577f * LOG2E;

__constant__ float INV_FREQ[16] = {1.0f, 0.5623413324356079f, 0.3162277638912201f, 0.17782793939113617f, 0.10000000149011612f, 0.05623413249850273f, 0.03162277489900589f, 0.017782794311642647f,
    0.009999999776482582f, 0.005623413249850273f, 0.003162277629598975f, 0.0017782794311642647f, 0.0010000000474974513f, 0.000562341301701963f, 0.0003162277571391314f, 0.00017782794020604342f};

namespace pg8 {
#define PG8_LAS __attribute__((address_space(3)))
typedef unsigned short bf16_t;
typedef short bf16x8 __attribute__((ext_vector_type(8)));
typedef float f32x4 __attribute__((ext_vector_type(4)));
typedef unsigned u32x4 __attribute__((ext_vector_type(4)));
constexpr int BM = 256, BK = 64, HALF = 128, HTB = HALF * BK * 2  , STAGE_BYTES = 8 * HTB, NXCD = 8, WGM = 8;

__host__ __device__ __forceinline__ int lds_byte(int r, int c) { const int st = (r >> 4) * 2 + (c >> 5), rr = r & 15, cc = c & 31, ob = rr * 64 + cc * 2; return st * 1024 + (ob ^ (((ob >> 9) & 1) << 5)); }
__host__ __device__ __forceinline__ void stage_rc(int b, int& R, int& C) { const int st = b / 1024, sb = b % 1024, swz = sb ^ (((sb >> 9) & 1) << 5); R = (st >> 1) * 16 + swz / 64; C = (st & 1) * 32 + (swz % 64) / 2; }
__host__ __device__ __forceinline__ int perm32(int rho) { const int n = rho >> 4, i = rho & 15; return 8 * (i >> 2) + 4 * n + (i & 3); }

struct Unit { int pm, pn; };
struct Gemm { const bf16_t* A; const bf16_t* Bt; int M, N, K, lda; };

struct StaticOrder {
    int nM, nN, nwg, G, c, flip;
    __host__ __device__ void init(int M, int N, int G_, int c_) { nM = M / BM; nN = N / BM; nwg = nM * nN; G = G_; c = c_; flip = 0; }
    __host__ __device__ bool next(int i, Unit& u) const {
        const long L = (long)i * G + c; if (L >= nwg) return false;
        int wgid = (int)L; { const int q = nwg / NXCD, r = nwg % NXCD, xcd = wgid % NXCD, off = wgid / NXCD; wgid = (xcd < r ? xcd * (q + 1) : r * (q + 1) + (xcd - r) * q) + off; }
        const int nig = WGM * nN, gid = wgid / nig, fm = gid * WGM;
        u.pm = fm + ((wgid % nig) % WGM); u.pn = (wgid % nig) / WGM; if (flip) u.pm = (u.pm & ~31) | (31 - (u.pm & 31)); return true;
    }
    __device__ __forceinline__ void a_ready(const Unit&) const {}
    __device__ __forceinline__ void done(const Unit&) const {}
};


__device__ __forceinline__ unsigned pk_bf16(float lo, float hi) { typedef float f2_t __attribute__((ext_vector_type(2))); typedef __bf16 b2_t __attribute__((ext_vector_type(2))); f2_t v = {lo, hi}; b2_t b = __builtin_convertvector(v, b2_t); return __builtin_bit_cast(unsigned, b); }
__device__ __forceinline__ float bf_lo(unsigned u) { return __builtin_bit_cast(float, u << 16); }
__device__ __forceinline__ float bf_hi(unsigned u) { return __builtin_bit_cast(float, u & 0xffff0000u); }
__device__ __forceinline__ float sigmoidf_(float x) { return __builtin_amdgcn_rcpf(1.0f + __builtin_amdgcn_exp2f(-1.4426950408889634f * x)); }
__device__ __forceinline__ int vperm16(int s) { return (s & 3) + ((s >> 3) & 1) * 4 + ((s >> 2) & 1) * 8; }

enum { EP_PLAIN = 0, EP_RELU2 = 1, EP_Z1 = 2, EP_QB = 3, EP_KVB = 4, EP_GATE = 5, EP_RESID = 6 };
struct Epi {
    static constexpr bool PERM = true, AFTER_DRAIN = false;
    int mode;
    bf16_t* O; int ldc;
    bf16_t* O2;
    bf16_t* O3;
    const bf16_t* Y1; const bf16_t* Y2;
    const float* cs;
    const float* base; float* outf;
    const float* rs; int rs_ld, rs_off, rs_n; float rs_inv;
    float* ss_out;
    bf16_t* xb;
    __device__ __forceinline__ void store8(bf16_t* p, f32x4 v0, f32x4 v1) const {
        u32x4 w; w.x = pk_bf16(v0[0], v0[1]); w.y = pk_bf16(v0[2], v0[3]); w.z = pk_bf16(v1[0], v1[1]); w.w = pk_bf16(v1[2], v1[3]); *(u32x4*)p = w; }
    __device__ __forceinline__ void storeT(bf16_t* vt  , int d0, int s, f32x4 v0, f32x4 v1) const {
        const int pos = (s & ~15) + vperm16(s & 15);
#pragma unroll
        for (int e = 0; e < 4; ++e) { vt[(size_t)(d0 + e) * SEQ + pos] = (bf16_t)(pk_bf16(v0[e], 0.f) & 0xffffu); vt[(size_t)(d0 + 4 + e) * SEQ + pos] = (bf16_t)(pk_bf16(v1[e], 0.f) & 0xffffu); }
    }
    __device__ __forceinline__ void rope8(f32x4& v0, f32x4& v1, const f32x4 (&c)[4], int fq) const {
        const float sg = (fq < 2) ? -1.f : 1.f;
#pragma unroll
        for (int e = 0; e < 4; ++e) {
            const float p0 = __shfl_xor(v0[e], 32), p1 = __shfl_xor(v1[e], 32);
            v0[e] = v0[e] * c[0][e] + sg * p0 * c[2][e]; v1[e] = v1[e] * c[1][e] + sg * p1 * c[3][e];
        }
    }
    __device__ __forceinline__ void operator()(const f32x4 (&acc)[2][2][4][2], const Unit& u, int wr, int wc, int fr, int fq) const {
        const int row0 = u.pm * BM + wr * 64 + fr;
        float rsc[2][4];
        if (rs_n > 0) {
            f32x4 part[2][4];
#pragma unroll
            for (int ai = 0; ai < 2; ++ai)
#pragma unroll
                for (int m = 0; m < 4; ++m) {
                    part[ai][m] = (f32x4){0.f, 0.f, 0.f, 0.f};
                    if (4 * fq < rs_n) part[ai][m] = *(const f32x4*)(rs + (size_t)(row0 + ai * HALF + m * 16) * rs_ld + rs_off + 4 * fq);
                }
#pragma unroll
            for (int ai = 0; ai < 2; ++ai)
#pragma unroll
                for (int m = 0; m < 4; ++m) {
                    float t = (part[ai][m][0] + part[ai][m][1]) + (part[ai][m][2] + part[ai][m][3]);
                    t += __shfl_xor(t, 16); t += __shfl_xor(t, 32);
                    rsc[ai][m] = __builtin_amdgcn_rsqf(t * rs_inv + EPS);
                }
        } else {
#pragma unroll
            for (int ai = 0; ai < 2; ++ai)
#pragma unroll
                for (int m = 0; m < 4; ++m) rsc[ai][m] = 1.0f;
        }
        const int grp0 = u.pn * 8 + wc;
        const bool rope0 = (mode == EP_QB) && (grp0 % 3 == 2), rope1 = (mode == EP_QB) ? ((grp0 + 4) % 3 == 2) : (mode == EP_Z1 && grp0 + 4 == 44);
        u32x4 yall[2][4][2];
#pragma unroll
        for (int aim = 0; aim < 4; ++aim) {
            const int ai = aim >> 1, mb = (aim & 1) * 2;
            if ((aim & 1) == 0) {
                if (mode == EP_GATE) {
#pragma unroll
                    for (int m = 0; m < 4; ++m) { const size_t off = (size_t)(row0 + ai * HALF + m * 16) * DM + u.pn * 128 + wc * 32 + 8 * fq; yall[ai][m][0] = *(const u32x4*)(Y1 + off); yall[ai][m][1] = *(const u32x4*)(Y2 + off); }
                }
                if (mode == EP_RESID) {
#pragma unroll
                    for (int m = 0; m < 4; ++m)
#pragma unroll
                        for (int bj = 0; bj < 2; ++bj) yall[ai][m][bj] = *(const u32x4*)(xb + (size_t)(row0 + ai * HALF + m * 16) * DM + u.pn * BM + bj * HALF + wc * 32 + 8 * fq);
                }
            }
            f32x4 cst[4][4];
            if (rope0 || rope1) {
#pragma unroll
                for (int m = mb; m < mb + 2; ++m) { const float* c = cs + (size_t)(row0 + ai * HALF + m * 16) * 32 + 8 * (fq & 1);
                    cst[m][0] = *(const f32x4*)c; cst[m][1] = *(const f32x4*)(c + 4); cst[m][2] = *(const f32x4*)(c + 16); cst[m][3] = *(const f32x4*)(c + 20); }
            }
#pragma unroll
            for (int m = mb; m < mb + 2; ++m) {
                const int row = row0 + ai * HALF + m * 16;
                const float rs1 = rsc[ai][m];
                if (mode == EP_GATE) {
                    const size_t off = (size_t)row * DM + u.pn * 128 + wc * 32 + 8 * fq;
                    const f32x4 a0 = acc[ai][0][m][0] * rs1, a1 = acc[ai][0][m][1] * rs1, b0 = acc[ai][1][m][0] * rs1, b1 = acc[ai][1][m][1] * rs1;
                    const u32x4 y1 = yall[ai][m][0], y2 = yall[ai][m][1];
                    f32x4 r0, r1;
                    r0[0] = sigmoidf_(a0[0]) * bf_lo(y1.x) + sigmoidf_(b0[0]) * bf_lo(y2.x); r0[1] = sigmoidf_(a0[1]) * bf_hi(y1.x) + sigmoidf_(b0[1]) * bf_hi(y2.x);
                    r0[2] = sigmoidf_(a0[2]) * bf_lo(y1.y) + sigmoidf_(b0[2]) * bf_lo(y2.y); r0[3] = sigmoidf_(a0[3]) * bf_hi(y1.y) + sigmoidf_(b0[3]) * bf_hi(y2.y);
                    r1[0] = sigmoidf_(a1[0]) * bf_lo(y1.z) + sigmoidf_(b1[0]) * bf_lo(y2.z); r1[1] = sigmoidf_(a1[1]) * bf_hi(y1.z) + sigmoidf_(b1[1]) * bf_hi(y2.z);
                    r1[2] = sigmoidf_(a1[2]) * bf_lo(y1.w) + sigmoidf_(b1[2]) * bf_lo(y2.w); r1[3] = sigmoidf_(a1[3]) * bf_hi(y1.w) + sigmoidf_(b1[3]) * bf_hi(y2.w);
                    store8(O + off, r0, r1);
                    continue;
                }
                float ssacc = 0.f;
#pragma unroll
                for (int bj = 0; bj < 2; ++bj) {
                    const int col8 = u.pn * BM + bj * HALF + wc * 32 + 8 * fq;
                    f32x4 v0 = acc[ai][bj][m][0] * rs1, v1 = acc[ai][bj][m][1] * rs1;
                    if (mode == EP_PLAIN) { store8(O + (size_t)row * ldc + col8, v0, v1); }
                    else if (mode == EP_RELU2) {
#pragma unroll
                        for (int e = 0; e < 4; ++e) { float a = fmaxf(v0[e], 0.f), b = fmaxf(v1[e], 0.f); v0[e] = a * a; v1[e] = b * b; }
                        store8(O + (size_t)row * ldc + col8, v0, v1);
                    } else if (mode == EP_Z1) {
                        const int grp = grp0 + bj * 4;
                        if (grp >= 20 && grp < 24) {
                            const int b = row / SEQ, s = row % SEQ, kvh = wc >> 1;
                            storeT(O2 + (size_t)(b * 2 + kvh) * 64 * SEQ, (wc & 1) * 32 + 8 * fq, s, v0, v1);
                        } else if (grp == 44) {
                            rope8(v0, v1, cst[m], fq);
                            bf16_t* kr = O3 + (size_t)row * NQB + 64 + 8 * fq;
#pragma unroll
                            for (int h = 0; h < 8; ++h) store8(kr + h * 96, v0, v1);
                        } else if (grp < 44) {
                            if (grp < 16) { v0 = v0 * QA_SCALE; v1 = v1 * QA_SCALE; }
                            store8(O + (size_t)row * ldc + col8, v0, v1);
                            if (grp >= 24) {
                                float q = (v0[0] * v0[0] + v0[1] * v0[1]) + (v0[2] * v0[2] + v0[3] * v0[3]) + (v1[0] * v1[0] + v1[1] * v1[1]) + (v1[2] * v1[2] + v1[3] * v1[3]);
                                q += __shfl_xor(q, 16); q += __shfl_xor(q, 32);
                                if (fq == 0) ss_out[(size_t)row * 32 + grp - 24] = q;
                            }
                        }
                    } else if (mode == EP_QB) {
                        if (bj == 0 ? rope0 : rope1) rope8(v0, v1, cst[m], fq);
                        v0 = v0 * QB_SCALE; v1 = v1 * QB_SCALE;
                        store8(O + (size_t)row * ldc + col8, v0, v1);
                    } else if (mode == EP_KVB) {
                        const int head = u.pn * 2 + bj;
                        if (wc < 2) store8(O2 + (size_t)row * NQB + head * 96 + wc * 32 + 8 * fq, v0, v1);
                        else { const int b = row / SEQ, s = row % SEQ; storeT(O3 + (size_t)(b * 8 + head) * 64 * SEQ, (wc - 2) * 32 + 8 * fq, s, v0, v1); }
                    } else {
                        const size_t off = (size_t)row * DM + col8;
                        const u32x4 xi = yall[ai][m][bj];
                        const f32x4 x0 = (f32x4){bf_lo(xi.x), bf_hi(xi.x), bf_lo(xi.y), bf_hi(xi.y)} + v0, x1 = (f32x4){bf_lo(xi.z), bf_hi(xi.z), bf_lo(xi.w), bf_hi(xi.w)} + v1;
                        store8(xb + off, x0, x1);
                        ssacc += (x0[0] * x0[0] + x0[1] * x0[1]) + (x0[2] * x0[2] + x0[3] * x0[3]) + (x1[0] * x1[0] + x1[1] * x1[1]) + (x1[2] * x1[2] + x1[3] * x1[3]);
                    }
                }
                if (mode == EP_RESID) {
                    ssacc += __shfl_xor(ssacc, 16); ssacc += __shfl_xor(ssacc, 32);
                    if (fq == 0) ss_out[(size_t)row * 16 + u.pn * 4 + wc] = ssacc;
                }
            }
        }
    }
};
template <class Epi, class Sched, bool ALIGN_EPI = false, bool SP2 = false>
__device__ __forceinline__ void gemm_phase(PG8_LAS unsigned char* lds, const Gemm g, const Sched& S, const Epi& E, int wv) {
    int tid_ = wv * 64 + hw_lane_id(); asm volatile("" : "+v"(tid_));
    const int tid = tid_, wid = __builtin_amdgcn_readfirstlane(tid >> 6), lane = tid & 63, wr = wid >> 2, wc = wid & 3, fr = lane & 15, fq = lane >> 4;
    const int K = g.K, nt = K / BK;
    unsigned voffA[2], voffB[2];
#pragma unroll
    for (int i = 0; i < 2; ++i) { int R, C; stage_rc(tid * 16 + i * 8192, R, C); const int Rb = Epi::PERM ? ((R & ~31) + perm32(R & 31)) : R;
        voffA[i] = (unsigned)(R * g.lda + C) * 2u; voffB[i] = (unsigned)(Rb * K + C) * 2u; }
    const size_t kstep = (size_t)(BK * 2);
    const size_t hstep = (size_t)HALF * K * 2, hstepA = (size_t)HALF * g.lda * 2;
    const size_t tstep = 2 * hstep, tstepA = 2 * hstepA;
    const unsigned ldsw = (unsigned)wid * 1024u;
    const int aoff = lds_byte(wr * 64 + fr, fq * 8), boff = lds_byte(wc * 32 + fr, fq * 8);
#define PG8_SA(b, h) (((b) * 2 + (h)) * HTB)
#define PG8_SB(b, h) ((4 + (b) * 2 + (h)) * HTB)
#define PG8_STAGE(bufoff, gbase, voff) do { _Pragma("unroll") for (int _i = 0; _i < 2; ++_i) \
        __builtin_amdgcn_global_load_lds((const unsigned*)((const char*)(gbase) + (voff)[_i]), (PG8_LAS unsigned*)(lds + (bufoff) + ldsw + _i * 8192), 16, 0, 0); } while (0)
#define PG8_LDA(dst, b, h) do { _Pragma("unroll") for (int m = 0; m < 4; ++m) _Pragma("unroll") for (int k = 0; k < 2; ++k) dst[m][k] = *(const PG8_LAS bf16x8*)(lds + PG8_SA(b, h) + aoff + m * 2048 + k * 1024); } while (0)
#define PG8_LDB(dst, b, h) do { _Pragma("unroll") for (int n = 0; n < 2; ++n) _Pragma("unroll") for (int k = 0; k < 2; ++k) dst[n][k] = *(const PG8_LAS bf16x8*)(lds + PG8_SB(b, h) + boff + n * 2048 + k * 1024); } while (0)
#define PG8_MMA(ai, bj, At, Bt) do { __builtin_amdgcn_s_setprio(1); _Pragma("unroll") for (int m = 0; m < 4; ++m) _Pragma("unroll") for (int n = 0; n < 2; ++n) _Pragma("unroll") for (int k = 0; k < 2; ++k) \
        acc[ai][bj][m][n] = __builtin_amdgcn_mfma_f32_16x16x32_bf16(Bt[n][k], At[m][k], acc[ai][bj][m][n], 0, 0, 0); __builtin_amdgcn_s_setprio(0); } while (0)
#define PG8_WAIT_V(n) asm volatile("s_waitcnt vmcnt(" #n ")" ::: "memory")
#define PG8_WAIT_L(n) asm volatile("s_waitcnt lgkmcnt(" #n ")" ::: "memory")
#define PG8_BAR __builtin_amdgcn_s_barrier()
#define PG8_SCHED __builtin_amdgcn_sched_barrier(0)
    Unit cur, nxt; int ui = 0;
    if (!S.next(0, cur)) return;
    f32x4 acc[2][2][4][2];
#pragma unroll
    for (int a = 0; a < 2; ++a)
#pragma unroll
        for (int b = 0; b < 2; ++b)
#pragma unroll
            for (int m = 0; m < 4; ++m)
#pragma unroll
                for (int n = 0; n < 2; ++n) acc[a][b][m][n] = (f32x4){0.f, 0.f, 0.f, 0.f};
    bf16x8 At[4][2], B0[2][2], B1[2][2];
    const char* cA = (const char*)g.A + (size_t)cur.pm * tstepA; const char* cB = (const char*)g.Bt + (size_t)cur.pn * tstep;
    S.a_ready(cur);
    if constexpr (SP2) {
        PG8_STAGE(PG8_SB(0, 0), cB, voffB); PG8_STAGE(PG8_SB(0, 1), cB + hstep, voffB); PG8_STAGE(PG8_SA(0, 0), cA, voffA); PG8_STAGE(PG8_SA(0, 1), cA + hstepA, voffA);
        if (wr == 1) PG8_BAR;
        PG8_WAIT_V(2); PG8_BAR;
        PG8_STAGE(PG8_SB(1, 0), cB + kstep, voffB); PG8_STAGE(PG8_SA(1, 0), cA + kstep, voffA); PG8_STAGE(PG8_SB(1, 1), cB + hstep + kstep, voffB);
        PG8_WAIT_V(6); PG8_BAR;
    } else {
        PG8_STAGE(PG8_SB(0, 0), cB, voffB); PG8_STAGE(PG8_SA(0, 0), cA, voffA); PG8_STAGE(PG8_SB(0, 1), cB + hstep, voffB); PG8_STAGE(PG8_SA(0, 1), cA + hstepA, voffA);
        if (wr == 1) PG8_BAR;
        PG8_WAIT_V(4); PG8_BAR;
        PG8_STAGE(PG8_SB(1, 0), cB + kstep, voffB); PG8_STAGE(PG8_SA(1, 0), cA + kstep, voffA); PG8_STAGE(PG8_SB(1, 1), cB + hstep + kstep, voffB);
        PG8_WAIT_V(6); PG8_BAR;
    }
    for (;;) {
        const bool has_next = S.next(ui + 1, nxt);
        const char* nA = has_next ? (const char*)g.A + (size_t)nxt.pm * tstepA : cA; const char* nB = has_next ? (const char*)g.Bt + (size_t)nxt.pn * tstep : cB;
        for (int t = 0; t < nt; t += 2) {
            const bool last = (t == nt - 2);
            const char* a1 = cA + (size_t)(t + 1) * kstep;
            const char* a2 = last ? nA : cA + (size_t)(t + 2) * kstep; const char* b2 = last ? nB : cB + (size_t)(t + 2) * kstep;
            const char* a3 = a2 + kstep; const char* b3 = b2 + kstep;
            if (last && has_next) S.a_ready(nxt);
            if constexpr (SP2) {
            PG8_LDB(B0, 0, 0); PG8_LDB(B1, 0, 1); PG8_SCHED; PG8_LDA(At, 0, 0); PG8_STAGE(PG8_SA(1, 1), a1 + hstepA, voffA);
            PG8_WAIT_V(8); PG8_WAIT_L(0); PG8_BAR; PG8_MMA(0, 0, At, B0); PG8_MMA(0, 1, At, B1); PG8_BAR; PG8_SCHED;
            PG8_LDA(At, 0, 1); PG8_STAGE(PG8_SB(0, 0), b2, voffB); PG8_STAGE(PG8_SB(0, 1), b2 + hstep, voffB); PG8_STAGE(PG8_SA(0, 0), a2, voffA);
            PG8_WAIT_V(8); PG8_WAIT_L(0); PG8_BAR; PG8_MMA(1, 0, At, B0); PG8_MMA(1, 1, At, B1); PG8_BAR; PG8_SCHED;
            PG8_LDB(B0, 1, 0); PG8_LDB(B1, 1, 1); PG8_SCHED; PG8_LDA(At, 1, 0); PG8_STAGE(PG8_SA(0, 1), a2 + hstepA, voffA);
            PG8_WAIT_V(8); PG8_WAIT_L(0); PG8_BAR; PG8_MMA(0, 0, At, B0); PG8_MMA(0, 1, At, B1); PG8_BAR; PG8_SCHED;
            PG8_LDA(At, 1, 1); PG8_STAGE(PG8_SB(1, 0), b3, voffB); PG8_STAGE(PG8_SB(1, 1), b3 + hstep, voffB); PG8_STAGE(PG8_SA(1, 0), a3, voffA);
            PG8_WAIT_V(8); PG8_WAIT_L(0); PG8_BAR; PG8_MMA(1, 0, At, B0); PG8_MMA(1, 1, At, B1); PG8_BAR; PG8_SCHED;
            } else {
            PG8_LDB(B0, 0, 0); PG8_SCHED; PG8_LDA(At, 0, 0); PG8_STAGE(PG8_SA(1, 1), a1 + hstepA, voffA);
            PG8_WAIT_L(8); PG8_BAR; PG8_WAIT_L(0); PG8_MMA(0, 0, At, B0); PG8_BAR; PG8_SCHED;
            PG8_LDB(B1, 0, 1); PG8_STAGE(PG8_SB(0, 0), b2, voffB);
            PG8_BAR; PG8_WAIT_L(0); PG8_MMA(0, 1, At, B1); PG8_BAR;
            PG8_LDA(At, 0, 1); PG8_STAGE(PG8_SA(0, 0), a2, voffA);
            PG8_BAR; PG8_WAIT_L(0); PG8_MMA(1, 0, At, B0); PG8_BAR; PG8_SCHED;
            PG8_STAGE(PG8_SB(0, 1), b2 + hstep, voffB);
            PG8_WAIT_V(6); PG8_BAR; PG8_MMA(1, 1, At, B1); PG8_BAR;
            PG8_LDB(B0, 1, 0); PG8_SCHED; PG8_LDA(At, 1, 0); PG8_STAGE(PG8_SA(0, 1), a2 + hstepA, voffA);
            PG8_WAIT_L(8); PG8_BAR; PG8_WAIT_L(0); PG8_MMA(0, 0, At, B0); PG8_BAR; PG8_SCHED;
            PG8_LDB(B1, 1, 1); PG8_STAGE(PG8_SB(1, 0), b3, voffB);
            PG8_BAR; PG8_WAIT_L(0); PG8_MMA(0, 1, At, B1); PG8_BAR;
            PG8_LDA(At, 1, 1); PG8_STAGE(PG8_SA(1, 0), a3, voffA);
            PG8_BAR; PG8_WAIT_L(0); PG8_MMA(1, 0, At, B0); PG8_BAR; PG8_SCHED;
            PG8_STAGE(PG8_SB(1, 1), b3 + hstep, voffB);
            PG8_WAIT_V(6); PG8_BAR; PG8_MMA(1, 1, At, B1); PG8_BAR;
            }
        }
        if constexpr (ALIGN_EPI) { if (wr == 0) PG8_BAR; }
        if constexpr (!Epi::AFTER_DRAIN) { E(acc, cur, wr, wc, fr, fq); S.done(cur); }
        if (!has_next) break;
#pragma unroll
        for (int a = 0; a < 2; ++a)
#pragma unroll
            for (int b = 0; b < 2; ++b)
#pragma unroll
                for (int m = 0; m < 4; ++m)
#pragma unroll
                    for (int n = 0; n < 2; ++n) acc[a][b][m][n] = (f32x4){0.f, 0.f, 0.f, 0.f};
        cur = nxt; cA = nA; cB = nB; ++ui;
        if constexpr (ALIGN_EPI) { if (wr == 1) PG8_BAR; }
    }
    PG8_WAIT_V(0);
    if constexpr (!ALIGN_EPI) { if (wr == 0) PG8_BAR; }
    PG8_BAR;
    if constexpr (Epi::AFTER_DRAIN) { E.fused(acc, cur, wr, wc, fr, fq, lds, wid, lane); S.done(cur); }
#undef PG8_SA
#undef PG8_SB
#undef PG8_STAGE
#undef PG8_LDA
#undef PG8_LDB
#undef PG8_MMA
#undef PG8_WAIT_V
#undef PG8_WAIT_L
#undef PG8_BAR
#undef PG8_SCHED
}
}
#define LAS __attribute__((address_space(3)))
using namespace pg8;
typedef float f32x16 __attribute__((ext_vector_type(16)));
#define MFMA32(a, b, c) __builtin_amdgcn_mfma_f32_32x32x16_bf16((a), (b), (c), 0, 0, 0)

constexpr size_t MiB = 1u << 20;
constexpr size_t WS_CTL = 0;
constexpr size_t WS_W = 1 * MiB, W_LAYER = 29 * MiB;
constexpr size_t WO_IN1 = 0, WO_G = 3 * MiB, WO_UQ = 7 * MiB, WO_UKV = 8 * MiB, WO_A = 9 * MiB, WO_B = 10 * MiB, WO_OUT = 11 * MiB, WO_FF1 = 13 * MiB, WO_FF2 = 21 * MiB;
constexpr size_t WS_CS = WS_W + DEPTH * W_LAYER;
constexpr size_t WS_H = WS_CS + 8 * MiB;
constexpr size_t WS_BIG = WS_H + 128 * MiB;
constexpr size_t B_Z1 = 0, B_CQN = 192 * MiB, B_CKVN = 240 * MiB, B_QB = 272 * MiB, B_KB = 368 * MiB, B_VT = 464 * MiB, B_OA = 192 * MiB, B_OB = 528 * MiB, B_VTA = 592 * MiB;
constexpr size_t B_YA = 0, B_YB = 272 * MiB, B_MERGED = 400 * MiB, B_HID = 0;
constexpr size_t WS_SS = WS_BIG + 608 * MiB;
constexpr size_t WS_SSL = WS_SS + 4 * MiB;
constexpr size_t WS_END = WS_SSL + 8 * MiB;
constexpr int LDS_BYTES = 131072 + 64;
constexpr size_t WS_BAR = 65536;

struct Params { const float* in[17]; float* out; unsigned char* ws; };

__device__ __forceinline__ float wave_sum(float v) {
#pragma unroll
    for (int o = 1; o < 64; o <<= 1) v += __shfl_xor(v, o);
    return v;
}

__device__ __forceinline__ void transpose_matrix(const float* W, int ldw, int K, int N, int cmap, const float* gk, bf16_t* WT, LAS unsigned* img, int tid, int vb, int nvb) {
    const int lane = tid & 63, w = tid >> 6;
    const int nblk = N / 256, items = (K / 64) * nblk;
    for (int it = vb; it < items; it += nvb) {
        const int kb = it / nblk, nb = it % nblk, n0 = nb * 256, k0 = kb * 64 + w * 8;
        float v[4][4][2];
#pragma unroll
        for (int j = 0; j < 4; ++j) {
            const int nn = n0 + 64 * j;
            int c0 = nn;
            if (cmap == 1) c0 = nn; else if (cmap == 2) c0 = 1440 + ((nn & 255) >> 7) * 1024 + (nn >> 8) * 128 + (nn & 127);
            const bool ok = (cmap != 1) || (nn + lane < 1440);
#pragma unroll
            for (int kp = 0; kp < 4; ++kp)
#pragma unroll
                for (int e = 0; e < 2; ++e) v[j][kp][e] = ok ? W[(size_t)(k0 + 2 * kp + e) * ldw + c0 + lane] : 0.f;
        }
        float g[8];
#pragma unroll
        for (int i = 0; i < 8; ++i) g[i] = gk ? gk[k0 + i] : 1.f;
        __syncthreads();
#pragma unroll
        for (int j = 0; j < 4; ++j)
#pragma unroll
            for (int kp = 0; kp < 4; ++kp) img[(64 * j + lane) * 33 + w * 4 + kp] = pk_bf16(v[j][kp][0] * g[2 * kp], v[j][kp][1] * g[2 * kp + 1]);
        __syncthreads();
#pragma unroll
        for (int i = 0; i < 4; ++i) {
            const int n = (tid >> 3) + 64 * i, c = tid & 7;
            const LAS unsigned* q = img + n * 33 + c * 4;
            u32x4 o; o.x = q[0]; o.y = q[1]; o.z = q[2]; o.w = q[3];
            *(u32x4*)(WT + (size_t)(n0 + n) * K + kb * 64 + c * 8) = o;
        }
    }
}

__device__ __forceinline__ void rms_row_bf16(const float* xrow, const float* g, bf16_t* orow, int lane) {
    const f32x4* xr = (const f32x4*)xrow + lane; const f32x4* gr = (const f32x4*)g + lane;
    f32x4 v[4]; float s = 0.f;
#pragma unroll
    for (int j = 0; j < 4; ++j) { v[j] = xr[64 * j]; s += (v[j].x * v[j].x + v[j].y * v[j].y) + (v[j].z * v[j].z + v[j].w * v[j].w); }
    const float rstd = __builtin_amdgcn_rsqf(wave_sum(s) * (1.f / DM) + EPS);
    unsigned long long* o8 = (unsigned long long*)orow + lane;
#pragma unroll
    for (int j = 0; j < 4; ++j) { const f32x4 gg = gr[64 * j];
        o8[64 * j] = (unsigned long long)pk_bf16(v[j].x * rstd * gg.x, v[j].y * rstd * gg.y) | ((unsigned long long)pk_bf16(v[j].z * rstd * gg.z, v[j].w * rstd * gg.w) << 32); }
}
__device__ __forceinline__ void final_rows2(const bf16_t* XB, const float* SS, const float* g, float* out, int row0, int row1, int lane) {
    const int rows[2] = {row0, row1};
    f32x4 pp[2][4]; u32x4 xi[2][2];
#pragma unroll
    for (int q = 0; q < 2; ++q) { const float* ss = SS + (size_t)rows[q] * 16;
#pragma unroll
        for (int i = 0; i < 4; ++i) pp[q][i] = *(const f32x4*)(ss + 4 * i);
        const u32x4* xr = (const u32x4*)(XB + (size_t)rows[q] * DM) + lane;
        xi[q][0] = xr[0]; xi[q][1] = xr[64]; }
    const f32x4* gr = (const f32x4*)g + 2 * lane;
    const f32x4 g00 = gr[0], g01 = gr[1], g10 = gr[128], g11 = gr[129];
#pragma unroll
    for (int q = 0; q < 2; ++q) {
        float t = 0.f;
#pragma unroll
        for (int i = 0; i < 4; ++i) t += (pp[q][i][0] + pp[q][i][1]) + (pp[q][i][2] + pp[q][i][3]);
        const float rstd = __builtin_amdgcn_rsqf(t * (1.f / DM) + EPS);
        f32x4* o = (f32x4*)(out + (size_t)rows[q] * DM) + 2 * lane;
        const u32x4 a = xi[q][0], b = xi[q][1];
        o[0] = (f32x4){bf_lo(a.x), bf_hi(a.x), bf_lo(a.y), bf_hi(a.y)} * rstd * g00; o[1] = (f32x4){bf_lo(a.z), bf_hi(a.z), bf_lo(a.w), bf_hi(a.w)} * rstd * g01;
        o[128] = (f32x4){bf_lo(b.x), bf_hi(b.x), bf_lo(b.y), bf_hi(b.y)} * rstd * g10; o[129] = (f32x4){bf_lo(b.z), bf_hi(b.z), bf_lo(b.w), bf_hi(b.w)} * rstd * g11;
    }
}
__device__ __forceinline__ void prologue_rows2(const float* x, const int* positions, bf16_t* XB, float* SS, float* CS, int row0, int row1, int lane) {
    f32x4 v[2][4]; float s[2] = {0.f, 0.f};
    const int rows[2] = {row0, row1};
#pragma unroll
    for (int q = 0; q < 2; ++q) { const f32x4* xr = (const f32x4*)(x + (size_t)rows[q] * DM) + lane;
#pragma unroll
        for (int j = 0; j < 4; ++j) v[q][j] = xr[64 * j]; }
    int pos[2] = {0, 0};
    if (lane < 16) { pos[0] = positions[row0]; pos[1] = positions[row1]; }
#pragma unroll
    for (int q = 0; q < 2; ++q) {
#pragma unroll
        for (int j = 0; j < 4; ++j) s[q] += (v[q][j].x * v[q][j].x + v[q][j].y * v[q][j].y) + (v[q][j].z * v[q][j].z + v[q][j].w * v[q][j].w);
        s[q] = wave_sum(s[q]);
        unsigned long long* o8 = (unsigned long long*)(XB + (size_t)rows[q] * DM) + lane;
#pragma unroll
        for (int j = 0; j < 4; ++j) o8[64 * j] = (unsigned long long)pk_bf16(v[q][j].x, v[q][j].y) | ((unsigned long long)pk_bf16(v[q][j].z, v[q][j].w) << 32);
        if (lane < 16) {
            SS[(size_t)rows[q] * 16 + lane] = (lane == 0) ? s[q] : 0.f;
            const float a = (float)pos[q] * INV_FREQ[lane];
            double t = (double)a * 0.15915494309189535; t -= rint(t);
            const float fr = (float)t;
            CS[(size_t)rows[q] * 32 + lane] = __builtin_amdgcn_cosf(fr); CS[(size_t)rows[q] * 32 + 16 + lane] = __builtin_amdgcn_sinf(fr);
        }
    }
}

__device__ __forceinline__ int crow(int i, int hh) { return (i & 3) + 8 * (i >> 2) + 4 * hh; }
__device__ __forceinline__ bf16x8 pack8(const f32x16& x, int s8) {
    u32x4 p; p.x = pk_bf16(x[s8 + 0], x[s8 + 1]); p.y = pk_bf16(x[s8 + 2], x[s8 + 3]); p.z = pk_bf16(x[s8 + 4], x[s8 + 5]); p.w = pk_bf16(x[s8 + 6], x[s8 + 7]);
    return __builtin_bit_cast(bf16x8, p);
}
__device__ __forceinline__ void xhalf_swap(float x, float& a, float& b) { a = x; b = x; asm volatile("s_nop 1\n\tv_permlane32_swap_b32 %0, %1\n\ts_nop 1" : "+v"(a), "+v"(b)); }
__device__ __forceinline__ float xhalf_max(float x) { float a, b; xhalf_swap(x, a, b); float m; asm("v_max3_f32 %0, %1, %2, %3" : "=v"(m) : "v"(x), "v"(a), "v"(b)); return m; }
__device__ __forceinline__ float xhalf_sum(float x) { float a, b; xhalf_swap(x, a, b); return a + b; }
constexpr float RESCALE_THR = 6.0f;
__device__ __forceinline__ float max3f(float a, float b, float c) { float r; asm("v_max3_f32 %0, %1, %2, %3" : "=v"(r) : "v"(a), "v"(b), "v"(c)); return r; }
__device__ __forceinline__ float max16(const f32x16& x) {
    const float a = max3f(x[0], x[1], x[2]), b = max3f(x[3], x[4], x[5]), c = max3f(x[6], x[7], x[8]), d = max3f(x[9], x[10], x[11]), e = max3f(x[12], x[13], x[14]);
    return max3f(max3f(a, b, c), max3f(d, e, x[15]), x[15]);
}
__device__ __forceinline__ void store_ot(bf16_t* orow  , const f32x16& o, int d0, int hh, float inv) {
#pragma unroll
    for (int g = 0; g < 4; ++g) {
        const unsigned lo = pk_bf16(o[4 * g] * inv, o[4 * g + 1] * inv), hi = pk_bf16(o[4 * g + 2] * inv, o[4 * g + 3] * inv);
        *(unsigned long long*)(orow + d0 + 8 * g + 4 * hh) = (unsigned long long)lo | ((unsigned long long)hi << 32);
    }
}

constexpr int MK_ROW = 208, MV_ROW = 144, MK_BYTES = 64 * MK_ROW, MV_BYTES = 64 * MV_ROW, MV_BASE = 2 * MK_BYTES;
__device__ __forceinline__ void mla_qk(f32x16& s0, f32x16& s1, const LAS unsigned char* kb, const bf16x8 (&qf)[6], int r, int hh) {
    bf16x8 ka[6], kc[6];
    const LAS unsigned char* kp = kb + r * MK_ROW + hh * 16;
#pragma unroll
    for (int s = 0; s < 6; ++s) { ka[s] = *(const LAS bf16x8*)(kp + s * 32); kc[s] = *(const LAS bf16x8*)(kp + 32 * MK_ROW + s * 32); }
    __builtin_amdgcn_sched_barrier(0);
#pragma unroll
    for (int i = 0; i < 16; ++i) { s0[i] = 0.f; s1[i] = 0.f; }
#pragma unroll
    for (int s = 0; s < 6; ++s) { s0 = MFMA32(ka[s], qf[s], s0); s1 = MFMA32(kc[s], qf[s], s1); }
}
__device__ __forceinline__ void mla_sm_pv(f32x16& s0, f32x16& s1, f32x16& o0, f32x16& o1, float& m, float& l, const LAS unsigned char* vbuf, int k0, int q0, int r, int hh) {
    bf16x8 va[4], vc[4];
    const LAS unsigned char* vb = vbuf + r * MV_ROW + hh * 16;
#pragma unroll
    for (int ks = 0; ks < 4; ++ks) { va[ks] = *(const LAS bf16x8*)(vb + ks * 32); vc[ks] = *(const LAS bf16x8*)(vb + 32 * MV_ROW + ks * 32); }
    __builtin_amdgcn_sched_barrier(0);
    if (k0 + 63 > q0) {
        const int qpos = q0 + r;
#pragma unroll
        for (int i = 0; i < 16; ++i) { const int kp = k0 + crow(i, hh); if (kp > qpos) s0[i] = -INFINITY; if (kp + 32 > qpos) s1[i] = -INFINITY; }
    }
    float mx = max3f(max16(s0), max16(s1), m); const float mn = max3f(mx, __shfl_xor(mx, 32), mx), alpha = __builtin_amdgcn_exp2f(m - mn); m = mn;
    float ps = 0.f;
#pragma unroll
    for (int i = 0; i < 16; ++i) { s0[i] = __builtin_amdgcn_exp2f(s0[i] - mn); s1[i] = __builtin_amdgcn_exp2f(s1[i] - mn); ps += s0[i] + s1[i]; }
    l = l * alpha + ps;
    if (__any(alpha != 1.0f)) {
#pragma unroll
        for (int i = 0; i < 16; ++i) { o0[i] *= alpha; o1[i] *= alpha; }
    }
#pragma unroll
    for (int ks = 0; ks < 4; ++ks) {
        const bf16x8 pb = (ks < 2) ? pack8(s0, 8 * (ks & 1)) : pack8(s1, 8 * (ks & 1));
        o0 = MFMA32(va[ks], pb, o0); o1 = MFMA32(vc[ks], pb, o1);
    }
}
__device__ __forceinline__ void mla_unit(LAS unsigned char* lds, const bf16_t* QB, const bf16_t* KB, const bf16_t* VT, bf16_t* OB, int b, int h, int qb, int wv) {
    int tid_ = wv * 64 + hw_lane_id(); asm volatile("" : "+v"(tid_));
    const int tid = tid_, lane = tid & 63, wid = __builtin_amdgcn_readfirstlane(tid >> 6), r = lane & 31, hh = lane >> 5;
    const int q0 = qb * 256 + wid * 32;
    const size_t rowbase = (size_t)b * SEQ;
    bf16x8 qf[6];
    { const bf16_t* qp = QB + (rowbase + q0 + r) * NQB + h * 96 + 8 * hh;
#pragma unroll
      for (int s = 0; s < 6; ++s) qf[s] = *(const bf16x8*)(qp + 16 * s); }
    f32x16 o0, o1;
#pragma unroll
    for (int i = 0; i < 16; ++i) { o0[i] = 0.f; o1[i] = 0.f; }
    float m = -INFINITY, l = 0.f;
    const int ntiles = 4 * (qb + 1), nact = (q0 + 31) / 64 + 1;
    const bool grpA = wid < 4;
    const int kA_key = tid / 12, kA_part = tid % 12, kC_key = (512 + (tid & 255)) / 12, kC_part = (512 + (tid & 255)) % 12, v_d = tid >> 3, v_part = tid & 7;
    const bf16_t* gKA = KB + (rowbase + kA_key) * NQB + h * 96 + kA_part * 8;
    const bf16_t* gKC = KB + (rowbase + kC_key) * NQB + h * 96 + kC_part * 8;
    const bf16_t* gV = VT + ((size_t)(b * 8 + h) * 64 + v_d) * SEQ + v_part * 8;
    const int lKA = kA_key * MK_ROW + kA_part * 16, lKC = kC_key * MK_ROW + kC_part * 16, lV = MV_BASE + v_d * MV_ROW + v_part * 16;
    u32x4 ra, rc, rv, ra1, rc1, xa, xc, xv, ya, yc, yv;
    ra = *(const u32x4*)gKA; rv = *(const u32x4*)gV; ra1 = *(const u32x4*)(gKA + (size_t)64 * NQB);
    rc = *(const u32x4*)gKC; rc1 = *(const u32x4*)(gKC + (size_t)64 * NQB);
    ya = *(const u32x4*)(gKA + (size_t)128 * NQB); yv = *(const u32x4*)(gV + 64); yc = *(const u32x4*)(gKC + (size_t)128 * NQB);
    __syncthreads();
    *(LAS u32x4*)(lds + lKA) = ra; *(LAS u32x4*)(lds + lV) = rv; *(LAS u32x4*)(lds + MK_BYTES + lKA) = ra1;
    *(LAS u32x4*)(lds + lKC) = rc; *(LAS u32x4*)(lds + MK_BYTES + lKC) = rc1;
    __syncthreads();
    f32x16 sa0, sa1, sb0, sb1;
    mla_qk(sa0, sa1, lds, qf, r, hh);
    const int tl = ntiles - 1;
#define MLA_ITER(T, C0, C1, N0, N1, RA, RC, RV, WA, WC, WV) do { const int t_ = (T); \
        { const int tk = (t_ + 3 < tl) ? t_ + 3 : tl, tv = (t_ + 2 < tl) ? t_ + 2 : tl; \
          RA = *(const u32x4*)(gKA + (size_t)tk * 64 * NQB); RC = *(const u32x4*)(gKC + (size_t)tk * 64 * NQB); RV = *(const u32x4*)(gV + tv * 64); } \
        if (grpA && t_ + 1 < nact) mla_qk(N0, N1, lds + ((t_ + 1) & 1) * MK_BYTES, qf, r, hh); \
        if (t_ < nact) mla_sm_pv(C0, C1, o0, o1, m, l, lds + MV_BASE + (t_ & 1) * MV_BYTES, t_ * 64, q0, r, hh); \
        if (!grpA && t_ + 1 < nact) mla_qk(N0, N1, lds + ((t_ + 1) & 1) * MK_BYTES, qf, r, hh); \
        *(LAS u32x4*)(lds + (t_ & 1) * MK_BYTES + lKA) = WA; *(LAS u32x4*)(lds + (t_ & 1) * MK_BYTES + lKC) = WC; \
        *(LAS u32x4*)(lds + ((t_ + 1) & 1) * MV_BYTES + lV) = WV; \
        __syncthreads(); } while (0)
#pragma unroll 1
    for (int t = 0; t < ntiles; t += 2) {
        MLA_ITER(t, sa0, sa1, sb0, sb1, xa, xc, xv, ya, yc, yv);
        MLA_ITER(t + 1, sb0, sb1, sa0, sa1, ya, yc, yv, xa, xc, xv);
    }
#undef MLA_ITER
    l += __shfl_xor(l, 32);
    const float inv = 1.0f / l;
    bf16_t* orow = OB + (rowbase + q0 + r) * 512 + h * 64;
    store_ot(orow, o0, 0, hh, inv); store_ot(orow, o1, 32, hh, inv);
}

__device__ __forceinline__ void mla_softmax(f32x16& s0, f32x16& s1, f32x16& o0, f32x16& o1, float& m, float& l, int k0, int qrow0, int r, int hh) {
    if (k0 + 63 > qrow0) {
        const int qpos = qrow0 + r;
#pragma unroll
        for (int i = 0; i < 16; ++i) { const int kp = k0 + crow(i, hh); if (kp > qpos) s0[i] = -INFINITY; if (kp + 32 > qpos) s1[i] = -INFINITY; }
    }
    const float a16 = max16(s0), b16 = max16(s1);
    const float mx = xhalf_max(max3f(a16, b16, b16));
    float alpha = 1.0f;
    if (__any(mx > m + RESCALE_THR)) {
        const float mn = fmaxf(m, mx); alpha = __builtin_amdgcn_exp2f(m - mn); m = mn;
#pragma unroll
        for (int i = 0; i < 16; ++i) { o0[i] *= alpha; o1[i] *= alpha; }
    }
    float ps = 0.f;
#pragma unroll
    for (int i = 0; i < 16; ++i) { s0[i] = __builtin_amdgcn_exp2f(s0[i] - m); s1[i] = __builtin_amdgcn_exp2f(s1[i] - m); ps += s0[i] + s1[i]; }
    l = l * alpha + ps;
}
constexpr int M2BUF = MK_BYTES + MV_BYTES;
__device__ __forceinline__ void mla_unit2(LAS unsigned char* lds, const bf16_t* QB, const bf16_t* KB, const bf16_t* VT, bf16_t* OB, int b, int h, int qb, int wv) {
    int tid_ = wv * 64 + hw_lane_id(); asm volatile("" : "+v"(tid_));
    const int tid = tid_, lane = tid & 63, wid = __builtin_amdgcn_readfirstlane(tid >> 6), r = lane & 31, hh = lane >> 5;
    const int q0 = qb * 512 + wid * 64;
    const size_t rowbase = (size_t)b * SEQ;
    bf16x8 qa[6], qbf[6];
    { const bf16_t* qp = QB + (rowbase + q0 + r) * NQB + h * 96 + 8 * hh;
#pragma unroll
      for (int s = 0; s < 6; ++s) { qa[s] = *(const bf16x8*)(qp + 16 * s); qbf[s] = *(const bf16x8*)(qp + (size_t)32 * NQB + 16 * s); } }
    f32x16 oa0, oa1, ob0, ob1;
#pragma unroll
    for (int i = 0; i < 16; ++i) { oa0[i] = 0.f; oa1[i] = 0.f; ob0[i] = 0.f; ob1[i] = 0.f; }
    float ma = -INFINITY, mb = -INFINITY, la = 0.f, lb = 0.f;
    const int ntiles = 8 * (qb + 1), nact = q0 / 64 + 1, tl = ntiles - 1;
    const int kA_key = tid / 12, kA_part = tid % 12, kC_key = (512 + (tid & 255)) / 12, kC_part = (512 + (tid & 255)) % 12, v_d = tid >> 3, v_part = tid & 7;
    const bf16_t* gKA = KB + (rowbase + kA_key) * NQB + h * 96 + kA_part * 8;
    const bf16_t* gKC = KB + (rowbase + kC_key) * NQB + h * 96 + kC_part * 8;
    const bf16_t* gV = VT + ((size_t)(b * 8 + h) * 64 + v_d) * SEQ + v_part * 8;
    const int lKA = kA_key * MK_ROW + kA_part * 16, lKC = kC_key * MK_ROW + kC_part * 16, lV = MK_BYTES + v_d * MV_ROW + v_part * 16;
    u32x4 ra = *(const u32x4*)gKA, rc = *(const u32x4*)gKC, rv = *(const u32x4*)gV;
    __syncthreads();
    *(LAS u32x4*)(lds + lKA) = ra; *(LAS u32x4*)(lds + lKC) = rc; *(LAS u32x4*)(lds + lV) = rv;
    __syncthreads();
#pragma unroll 1
    for (int t = 0; t < ntiles; ++t) {
        LAS unsigned char* cur = lds + (t & 1) * M2BUF;
        { const int tn = (t + 1 < tl) ? t + 1 : tl;
          ra = *(const u32x4*)(gKA + (size_t)tn * 64 * NQB); rc = *(const u32x4*)(gKC + (size_t)tn * 64 * NQB); rv = *(const u32x4*)(gV + tn * 64); }
        if (t < nact) {
            const int k0 = t * 64;
            f32x16 sa0, sa1, sb0, sb1;
            { const LAS unsigned char* kp = cur + r * MK_ROW + hh * 16;
#pragma unroll
              for (int i = 0; i < 16; ++i) { sa0[i] = 0.f; sa1[i] = 0.f; sb0[i] = 0.f; sb1[i] = 0.f; }
#pragma unroll
              for (int hf = 0; hf < 2; ++hf) {
                  bf16x8 ka[3], kc[3];
#pragma unroll
                  for (int s = 0; s < 3; ++s) { ka[s] = *(const LAS bf16x8*)(kp + (3 * hf + s) * 32); kc[s] = *(const LAS bf16x8*)(kp + 32 * MK_ROW + (3 * hf + s) * 32); }
                  __builtin_amdgcn_sched_barrier(0);
#pragma unroll
                  for (int s = 0; s < 3; ++s) { sa0 = MFMA32(ka[s], qa[3 * hf + s], sa0); sa1 = MFMA32(kc[s], qa[3 * hf + s], sa1); sb0 = MFMA32(ka[s], qbf[3 * hf + s], sb0); sb1 = MFMA32(kc[s], qbf[3 * hf + s], sb1); }
                  __builtin_amdgcn_sched_barrier(0);
              } }
            mla_softmax(sa0, sa1, oa0, oa1, ma, la, k0, q0, r, hh);
            const LAS unsigned char* vb = cur + MK_BYTES + r * MV_ROW + hh * 16;
            mla_softmax(sb0, sb1, ob0, ob1, mb, lb, k0, q0 + 32, r, hh);
            bf16x8 v0 = *(const LAS bf16x8*)vb, v1 = *(const LAS bf16x8*)(vb + 32 * MV_ROW);
#pragma unroll
            for (int ks = 0; ks < 4; ++ks) {
                bf16x8 n0 = v0, n1 = v1;
                if (ks < 3) { n0 = *(const LAS bf16x8*)(vb + (ks + 1) * 32); n1 = *(const LAS bf16x8*)(vb + 32 * MV_ROW + (ks + 1) * 32); }
                const bf16x8 pa = (ks < 2) ? pack8(sa0, 8 * (ks & 1)) : pack8(sa1, 8 * (ks & 1));
                const bf16x8 pb = (ks < 2) ? pack8(sb0, 8 * (ks & 1)) : pack8(sb1, 8 * (ks & 1));
                oa0 = MFMA32(v0, pa, oa0); oa1 = MFMA32(v1, pa, oa1); ob0 = MFMA32(v0, pb, ob0); ob1 = MFMA32(v1, pb, ob1);
                v0 = n0; v1 = n1;
            }
        }
        { LAS unsigned char* nxt = lds + ((t + 1) & 1) * M2BUF;
          *(LAS u32x4*)(nxt + lKA) = ra; *(LAS u32x4*)(nxt + lKC) = rc; *(LAS u32x4*)(nxt + lV) = rv; }
        __syncthreads();
    }
    la = xhalf_sum(la); lb = xhalf_sum(lb);
    const float ia = 1.0f / la, ib = 1.0f / lb;
    bf16_t* orow = OB + (rowbase + q0 + r) * 512 + h * 64;
    store_ot(orow, oa0, 0, hh, ia); store_ot(orow, oa1, 32, hh, ia);
    store_ot(orow + (size_t)32 * 512, ob0, 0, hh, ib); store_ot(orow + (size_t)32 * 512, ob1, 32, hh, ib);
}

constexpr int SK_ROW = 144, SV_ROW = 528, SK_BYTES = 256 * SK_ROW, SV_BYTES = 64 * SV_ROW, S_BIAS = SK_BYTES + SV_BYTES;
__device__ __forceinline__ void swa_unit(LAS unsigned char* lds, const bf16_t* Z1, const bf16_t* VTA, const float* bias2, const float* sinks, bf16_t* OA, int b, int kvh, int qblk, int wv) {
    int tid_ = wv * 64 + hw_lane_id(); asm volatile("" : "+v"(tid_));
    const int tid = tid_, lane = tid & 63, wid = __builtin_amdgcn_readfirstlane(tid >> 6), r = lane & 31, hh = lane >> 5;
    const int Q0 = qblk * 128;
    const size_t rowbase = (size_t)b * SEQ;
    u32x4 kst[4], vst[4];
#pragma unroll
    for (int i = 0; i < 4; ++i) { const int c = tid + 512 * i, key = c >> 3, part = c & 7, kp = Q0 - 128 + key, kq = kp < 0 ? 0 : kp;
        kst[i] = *(const u32x4*)(Z1 + (rowbase + kq) * N1 + 512 + kvh * 64 + part * 8); }
#pragma unroll
    for (int i = 0; i < 4; ++i) { const int c = tid + 512 * i, d = c >> 5, part = c & 31, kp = Q0 - 128 + part * 8, kq = kp < 0 ? 0 : kp;
        vst[i] = *(const u32x4*)(VTA + ((size_t)(b * 2 + kvh) * 64 + d) * SEQ + kq); }
    const float bias_v = bias2[(kvh * 4 + (tid >> 7)) * 128 + (tid & 127)];
    __syncthreads();
#pragma unroll
    for (int i = 0; i < 4; ++i) { const int c = tid + 512 * i, key = c >> 3, part = c & 7, kp = Q0 - 128 + key;
        u32x4 v = kst[i]; if (kp < 0) v = (u32x4){0u, 0u, 0u, 0u};
        *(LAS u32x4*)(lds + key * SK_ROW + part * 16) = v; }
#pragma unroll
    for (int i = 0; i < 4; ++i) { const int c = tid + 512 * i, d = c >> 5, part = c & 31, kp = Q0 - 128 + part * 8;
        u32x4 v = vst[i]; if (kp < 0) v = (u32x4){0u, 0u, 0u, 0u};
        *(LAS u32x4*)(lds + SK_BYTES + d * SV_ROW + part * 16) = v; }
    ((LAS float*)(lds + S_BIAS))[tid] = bias_v;
    __syncthreads();
    const int g = wid & 3, half = wid >> 2, head = kvh * 4 + g;
    const LAS float* bl = (const LAS float*)(lds + S_BIAS) + g * 128;
    const float sink2 = sinks[head] * LOG2E;
#pragma unroll
    for (int sub = 0; sub < 2; ++sub) {
        const int q0w = 64 * half + 32 * sub;
        bf16x8 qf[4];
        { const bf16_t* qp = Z1 + (rowbase + Q0 + q0w + r) * N1 + head * 64 + 8 * hh;
#pragma unroll
          for (int s = 0; s < 4; ++s) qf[s] = *(const bf16x8*)(qp + 16 * s); }
        f32x16 o0, o1;
#pragma unroll
        for (int i = 0; i < 16; ++i) { o0[i] = 0.f; o1[i] = 0.f; }
        float m = sink2, l = (hh == 0) ? 1.f : 0.f;
#pragma unroll
        for (int kt = 0; kt < 5; ++kt) {
            const int kb = q0w + 32 * kt;
            if (Q0 == 0 && kb + 31 < 128) continue;
            f32x16 sc;
#pragma unroll
            for (int i = 0; i < 16; ++i) sc[i] = 0.f;
#pragma unroll
            for (int s = 0; s < 4; ++s) { const bf16x8 a = *(const LAS bf16x8*)(lds + (kb + r) * SK_ROW + s * 32 + hh * 16); sc = MFMA32(a, qf[s], sc); }
#pragma unroll
            for (int i = 0; i < 16; ++i) { const int c = crow(i, hh), dist = 128 - 32 * kt + r - c;
                const bool ok = (dist >= 0) && (dist < 128) && (Q0 > 0 || kb + c >= 128);
                sc[i] = ok ? sc[i] + bl[dist & 127] : -INFINITY; }
            const float mx = xhalf_max(max16(sc));
            float alpha = 1.0f;
            if (__any(mx > m + RESCALE_THR)) {
                const float mn = fmaxf(m, mx); alpha = __builtin_amdgcn_exp2f(m - mn); m = mn;
#pragma unroll
                for (int i = 0; i < 16; ++i) { o0[i] *= alpha; o1[i] *= alpha; }
            }
            float ps = 0.f;
#pragma unroll
            for (int i = 0; i < 16; ++i) { sc[i] = __builtin_amdgcn_exp2f(sc[i] - m); ps += sc[i]; }
            l = l * alpha + ps;
            const LAS unsigned char* vb = lds + SK_BYTES + r * SV_ROW + kb * 2 + hh * 16;
#pragma unroll
            for (int ks = 0; ks < 2; ++ks) {
                const bf16x8 pb = pack8(sc, 8 * ks);
                const bf16x8 v0 = *(const LAS bf16x8*)(vb + ks * 32), v1 = *(const LAS bf16x8*)(vb + 32 * SV_ROW + ks * 32);
                o0 = MFMA32(v0, pb, o0); o1 = MFMA32(v1, pb, o1);
            }
        }
        l = xhalf_sum(l);
        const float inv = 1.0f / l;
        bf16_t* orow = OA + (rowbase + Q0 + q0w + r) * 512 + head * 64;
        store_ot(orow, o0, 0, hh, inv); store_ot(orow, o1, 32, hh, inv);
    }
}

#define XB_TMO      128
#define XB_XCNT(j)  (256  + 64 * (j))
#define XB_XSUB(j)  (1280 + 64 * (j))
#define XB_XGEN(j)  (2304 + 64 * (j))
#define XB_TOP      3328
#define XB_TOPGEN   3392
#define XCD_BAR_WORDS 3456
#define XB_SPIN_CAP (1u << 18)

__device__ __forceinline__ unsigned xb_ld(unsigned* p)              { return __hip_atomic_load(p, __ATOMIC_RELAXED, __HIP_MEMORY_SCOPE_AGENT); }
__device__ __forceinline__ unsigned xb_add(unsigned* p, unsigned v) { return __hip_atomic_fetch_add(p, v, __ATOMIC_RELAXED, __HIP_MEMORY_SCOPE_AGENT); }
__device__ __forceinline__ unsigned xb_xcc_id() { return (unsigned)__builtin_amdgcn_s_getreg((3 << 11) | 20) & 0xFu; }
#define XB_SPIN(cond, bar) do { unsigned _sp = 0; while (cond) { __builtin_amdgcn_s_sleep(1); \
    if ((++_sp & 255u) == 0u) { if (xb_ld(&(bar)[XB_TMO])) break; if (_sp > XB_SPIN_CAP) { atomicAdd(&(bar)[XB_TMO], 1u); break; } } } } while (0)

struct XcdBarrier {
    unsigned* bar; unsigned x;
    volatile LAS unsigned* st;
};

__device__ __forceinline__ XcdBarrier xcd_barrier_post(unsigned* bar, volatile LAS unsigned* st) {
    XcdBarrier b; b.bar = bar; b.x = xb_xcc_id(); b.st = st;
    if (threadIdx.x == 0) (void)xb_add(&bar[XB_XCNT(b.x)], 1u);
    return b;
}
__device__ __forceinline__ void xcd_barrier_complete(unsigned* bar, unsigned x, unsigned& nloc, unsigned& nx) {
    const unsigned G = gridDim.x * gridDim.y * gridDim.z;
    unsigned sum, cnt, mine, sp = 0u;
    for (;;) {
        sum = 0u; cnt = 0u; mine = 0u;
#pragma unroll
        for (unsigned j = 0; j < 16; ++j) { const unsigned c = xb_ld(&bar[XB_XCNT(j)]); sum += c; cnt += (c > 0u) ? 1u : 0u; mine = (j == x) ? c : mine; }
        if (sum == G) break;
        __builtin_amdgcn_s_sleep(1);
        if ((++sp & 255u) == 0u) { if (xb_ld(&bar[XB_TMO])) break; if (sp > XB_SPIN_CAP) { atomicAdd(&bar[XB_TMO], 1u); break; } }
    }
    nloc = mine > 0u ? mine : 1u; nx = cnt > 0u ? cnt : 1u;
}

__device__ __forceinline__ void xcd_barrier(const XcdBarrier& b, const bool t0) {
    asm volatile("s_waitcnt vmcnt(0)" ::: "memory");
    __syncthreads();
    if (t0) {
        unsigned* bar = b.bar;
        __builtin_amdgcn_s_waitcnt(0);
        unsigned nloc = b.st[0], nx = b.st[1];
        if (nloc == 0u) { xcd_barrier_complete(bar, b.x, nloc, nx); b.st[0] = nloc; b.st[1] = nx; }
        const unsigned old = xb_add(&bar[XB_XSUB(b.x)], 1u);
        const unsigned gen = old / nloc;
        if (old + 1u == (gen + 1u) * nloc) {
            __builtin_amdgcn_fence(__ATOMIC_RELEASE, "agent");
            asm volatile("s_waitcnt vmcnt(0)" ::: "memory");
            const unsigned og = xb_add(&bar[XB_TOP], 1u);
            const unsigned tg = og / nx;
            if (og + 1u == (tg + 1u) * nx) xb_add(&bar[XB_TOPGEN], 1u);
            else XB_SPIN(xb_ld(&bar[XB_TOPGEN]) == tg, bar);
            __builtin_amdgcn_fence(__ATOMIC_ACQUIRE, "agent");
            xb_add(&bar[XB_XGEN(b.x)], 1u);
            asm volatile("s_waitcnt vmcnt(0)" ::: "memory");
        } else {
            XB_SPIN(xb_ld(&bar[XB_XGEN(b.x)]) == gen, bar);
            __builtin_amdgcn_fence(__ATOMIC_ACQUIRE, "agent");
            asm volatile("s_waitcnt vmcnt(0)" ::: "memory");
        }
    }
    __syncthreads();
}

template <class E> __device__ __forceinline__ void run_gemm(LAS unsigned char* lds, const bf16_t* A, const bf16_t* Bt, int lda, int Mrows, int N, int K, const E& e, int wv, int flip = 0) {
    pg8::Gemm g{A, Bt, Mrows, N, K, lda}; pg8::StaticOrder S; S.init(Mrows, N, (int)gridDim.x, (int)blockIdx.x); S.flip = flip;
    pg8::gemm_phase<E, pg8::StaticOrder, true, true>(lds, g, S, e, wv);
}

__global__ void __launch_bounds__(512) fwd_megakernel(Params p) {
    extern __shared__ __attribute__((aligned(16))) unsigned char lds_raw[];
    LAS unsigned char* lds = (LAS unsigned char*)lds_raw;
    cg::grid_group grid = cg::this_grid();
    if (threadIdx.x < 16) ((LAS unsigned*)(lds + 131072))[threadIdx.x] = 0u;
    __syncthreads();
    const XcdBarrier xbar = xcd_barrier_post((unsigned*)(p.ws + WS_CTL + WS_BAR), (volatile LAS unsigned*)(lds + 131072));
    const int wave = __builtin_amdgcn_readfirstlane(threadIdx.x >> 6);
#define FRESH_LANE() int tid = wave * 64 + hw_lane_id(); asm volatile("" : "+v"(tid)); const int lane = tid & 63
    const int G = gridDim.x, bx = blockIdx.x;
    const int vcu = (G % 8 == 0) ? (bx % 8) * (G / 8) + bx / 8 : bx;
    const int gw = vcu * 8 + wave, ngw = G * 8;
#define GAS __attribute__((address_space(1)))
#define FRESH(w) unsigned char* w; { GAS unsigned char* g_ = (GAS unsigned char*)p.ws; asm volatile("" : "+s"(g_)); w = (unsigned char*)g_; }
#define BIGP(w, off) ((bf16_t*)((w) + WS_BIG + (off)))

    {
        LAS unsigned* scr = (LAS unsigned*)lds;
        FRESH(ws); FRESH_LANE();
#pragma unroll 1
        for (int l = 0; l < DEPTH; ++l) {
            unsigned char* wl = ws + WS_W + (size_t)l * W_LAYER;
            const float* w_in = p.in[4] + (size_t)l * DM * D_IN;
            transpose_matrix(w_in, D_IN, DM, N1, 1, p.in[3] + l * DM, (bf16_t*)(wl + WO_IN1), scr, tid, vcu, G);
            transpose_matrix(w_in, D_IN, DM, NGATE, 2, p.in[3] + l * DM, (bf16_t*)(wl + WO_G), scr, tid, vcu, G);
            transpose_matrix(p.in[8] + (size_t)l * QL * NQB, NQB, QL, NQB, 0, p.in[6] + l * QL, (bf16_t*)(wl + WO_UQ), scr, tid, vcu, G);
            transpose_matrix(p.in[9] + (size_t)l * KVL * NKVB, NKVB, KVL, NKVB, 0, p.in[7] + l * KVL, (bf16_t*)(wl + WO_UKV), scr, tid, vcu, G);
            transpose_matrix(p.in[10] + (size_t)l * 512 * DM, DM, 512, DM, 0, nullptr, (bf16_t*)(wl + WO_A), scr, tid, vcu, G);
            transpose_matrix(p.in[11] + (size_t)l * 512 * DM, DM, 512, DM, 0, nullptr, (bf16_t*)(wl + WO_B), scr, tid, vcu, G);
            transpose_matrix(p.in[12] + (size_t)l * DM * DM, DM, DM, DM, 0, nullptr, (bf16_t*)(wl + WO_OUT), scr, tid, vcu, G);
            transpose_matrix(p.in[14] + (size_t)l * DM * DFF, DFF, DM, DFF, 0, p.in[13] + l * DM, (bf16_t*)(wl + WO_FF1), scr, tid, vcu, G);
            transpose_matrix(p.in[15] + (size_t)l * DFF * DM, DM, DFF, DM, 0, nullptr, (bf16_t*)(wl + WO_FF2), scr, tid, vcu, G);
        }
        if (bx == 0) {
            for (int t = tid; t < 1024; t += 512) {
                const int h = t >> 7, dist = t & 127; int bucket = dist;
                if (dist >= 16) { int lg = 16 + (int)(logf((float)dist / 16.0f) / 2.0794415416798357f * 16.0f); bucket = lg < 31 ? lg : 31; }
                ((float*)(ws + WS_CTL))[t] = p.in[2][bucket * 8 + h] * LOG2E;
            }
        }
        __syncthreads();
        for (int row = gw; row < MTOK; row += 2 * ngw)
            prologue_rows2(p.in[0], (const int*)p.in[1], (bf16_t*)(ws + WS_H), (float*)(ws + WS_SS), (float*)(ws + WS_CS), row, (row + ngw < MTOK) ? row + ngw : row, lane);
    }
    grid.sync();

#pragma unroll 1
    for (int l = 0; l < DEPTH; ++l) {
        const size_t wl = WS_W + (size_t)l * W_LAYER;
        Epi e{};
        { FRESH(ws); e = Epi{}; e.mode = EP_Z1; e.O = BIGP(ws, B_Z1); e.ldc = N1; e.O2 = BIGP(ws, B_VTA); e.O3 = BIGP(ws, B_KB); e.cs = (const float*)(ws + WS_CS);
          e.rs = (const float*)(ws + WS_SS); e.rs_ld = 16; e.rs_off = 0; e.rs_n = 16; e.rs_inv = 1.f / DM; e.ss_out = (float*)(ws + WS_SSL);
          run_gemm(lds, (const bf16_t*)(ws + WS_H), (const bf16_t*)(ws + wl + WO_IN1), DM, MTOK, N1, DM, e, wave, 1); }
        xcd_barrier(xbar, wave == 0 && hw_lane_id() == 0);
        { FRESH(ws); e = Epi{}; e.mode = EP_QB; e.O = BIGP(ws, B_QB); e.ldc = NQB; e.cs = (const float*)(ws + WS_CS);
          e.rs = (const float*)(ws + WS_SSL); e.rs_ld = 32; e.rs_off = 0; e.rs_n = 12; e.rs_inv = 1.f / QL;
          run_gemm(lds, BIGP(ws, B_Z1) + 768, (const bf16_t*)(ws + wl + WO_UQ), N1, MTOK, NQB, QL, e, wave); }
        { FRESH(ws); e = Epi{}; e.mode = EP_KVB; e.O2 = BIGP(ws, B_KB); e.O3 = BIGP(ws, B_VT);
          e.rs = (const float*)(ws + WS_SSL); e.rs_ld = 32; e.rs_off = 12; e.rs_n = 8; e.rs_inv = 1.f / KVL;
          run_gemm(lds, BIGP(ws, B_Z1) + 1152, (const bf16_t*)(ws + wl + WO_UKV), N1, MTOK, NKVB, KVL, e, wave); }
        xcd_barrier(xbar, wave == 0 && hw_lane_id() == 0);
        { FRESH(ws);
#pragma unroll 1
          for (int it = vcu; it < 512; it += G) {
            const int itl = (it & 31) + 32 * (it >> 8), bh = (G == 256) ? ((it >> 5) & 7) * 8 + (itl >> 3) : (it >> 3), pr = (G == 256) ? (itl & 7) : (it & 7);
#pragma unroll 1
            for (int k = 0; k < 2; ++k) mla_unit2(lds, BIGP(ws, B_QB), BIGP(ws, B_KB), BIGP(ws, B_VT), BIGP(ws, B_OB), bh >> 3, bh & 7, k ? pr : 15 - pr, wave);
          } }
        { FRESH(ws);
#pragma unroll 1
          for (int it = vcu; it < 1024; it += G) {
            const int itl = (it & 31) + 32 * (it >> 8), bk = (G == 256) ? ((it >> 5) & 7) * 2 + (itl >> 6) : (it >> 6), qblk = (G == 256) ? (itl & 63) : (it & 63);
            swa_unit(lds, BIGP(ws, B_Z1), BIGP(ws, B_VTA), (const float*)(ws + WS_CTL), p.in[5] + l * 8, BIGP(ws, B_OA), bk >> 1, bk & 1, qblk, wave);
          } }
        xcd_barrier(xbar, wave == 0 && hw_lane_id() == 0);
        { FRESH(ws); e = Epi{}; e.mode = EP_PLAIN; e.O = BIGP(ws, B_YA); e.ldc = DM;
          run_gemm(lds, BIGP(ws, B_OA), (const bf16_t*)(ws + wl + WO_A), 512, MTOK, DM, 512, e, wave); }
        { FRESH(ws); e = Epi{}; e.mode = EP_PLAIN; e.O = BIGP(ws, B_YB); e.ldc = DM;
          run_gemm(lds, BIGP(ws, B_OB), (const bf16_t*)(ws + wl + WO_B), 512, MTOK, DM, 512, e, wave); }
        xcd_barrier(xbar, wave == 0 && hw_lane_id() == 0);
        { FRESH(ws); e = Epi{}; e.mode = EP_GATE; e.O = BIGP(ws, B_MERGED); e.Y1 = BIGP(ws, B_YA); e.Y2 = BIGP(ws, B_YB);
          e.rs = (const float*)(ws + WS_SS); e.rs_ld = 16; e.rs_off = 0; e.rs_n = 16; e.rs_inv = 1.f / DM;
          run_gemm(lds, (const bf16_t*)(ws + WS_H), (const bf16_t*)(ws + wl + WO_G), DM, MTOK, NGATE, DM, e, wave, 1); }
        xcd_barrier(xbar, wave == 0 && hw_lane_id() == 0);
        { FRESH(ws); e = Epi{}; e.mode = EP_RESID; e.xb = (bf16_t*)(ws + WS_H); e.ss_out = (float*)(ws + WS_SS);
          run_gemm(lds, BIGP(ws, B_MERGED), (const bf16_t*)(ws + wl + WO_OUT), DM, MTOK, DM, DM, e, wave); }
        xcd_barrier(xbar, wave == 0 && hw_lane_id() == 0);
        { FRESH(ws); e = Epi{}; e.mode = EP_RELU2; e.O = BIGP(ws, B_HID); e.ldc = DFF;
          e.rs = (const float*)(ws + WS_SS); e.rs_ld = 16; e.rs_off = 0; e.rs_n = 16; e.rs_inv = 1.f / DM;
          run_gemm(lds, (const bf16_t*)(ws + WS_H), (const bf16_t*)(ws + wl + WO_FF1), DM, MTOK, DFF, DM, e, wave, 1); }
        xcd_barrier(xbar, wave == 0 && hw_lane_id() == 0);
        { FRESH(ws); e = Epi{}; e.mode = EP_RESID; e.xb = (bf16_t*)(ws + WS_H); e.ss_out = (float*)(ws + WS_SS);
          run_gemm(lds, BIGP(ws, B_HID), (const bf16_t*)(ws + wl + WO_FF2), DFF, MTOK, DM, DFF, e, wave, 0); }
        xcd_barrier(xbar, wave == 0 && hw_lane_id() == 0);
    }
    { FRESH(ws); FRESH_LANE();
      for (int row = gw; row < MTOK; row += 2 * ngw) final_rows2((const bf16_t*)(ws + WS_H), (const float*)(ws + WS_SS), p.in[16], p.out, row, (row + ngw < MTOK) ? row + ngw : row, lane); }
}

extern "C" void kernel_launch(void* const* d_in, const int* in_sizes, int n_in, void* d_out, int out_size, void* d_ws, size_t ws_size, hipStream_t stream) {
    static int grid_blocks = 0;
    if (grid_blocks == 0) {
        if (n_in != 17 || out_size != MTOK * DM || ws_size < WS_END) { fprintf(stderr, "kernel_launch: unexpected shapes (n_in %d out %d ws %zu, need %zu)\n", n_in, out_size, ws_size, (size_t)WS_END); grid_blocks = -1; return; }
        int dev = 0, cus = 0, per_cu = 0;
        hipGetDevice(&dev);
        hipDeviceGetAttribute(&cus, hipDeviceAttributeMultiprocessorCount, dev);
        if (hipFuncSetAttribute((const void*)fwd_megakernel, hipFuncAttributeMaxDynamicSharedMemorySize, LDS_BYTES) != hipSuccess) { fprintf(stderr, "kernel_launch: hipFuncSetAttribute failed\n"); grid_blocks = -1; return; }
        if (hipOccupancyMaxActiveBlocksPerMultiprocessor(&per_cu, (const void*)fwd_megakernel, 512, LDS_BYTES) != hipSuccess || per_cu < 1) { fprintf(stderr, "kernel_launch: occupancy query gave %d\n", per_cu); per_cu = 1; }
        (void)hipGetLastError();
        grid_blocks = cus;
    }
    if (grid_blocks < 0) return;
    if (hipMemsetAsync((char*)d_ws + WS_CTL + WS_BAR, 0, XCD_BAR_WORDS * 4, stream) != hipSuccess) { fprintf(stderr, "kernel_launch: memset failed\n"); return; }
    Params p{};
    for (int i = 0; i < 17; ++i) p.in[i] = (const float*)d_in[i];
    p.out = (float*)d_out; p.ws = (unsigned char*)d_ws;
    void* args[] = {&p};
    hipError_t e = hipLaunchCooperativeKernel((const void*)fwd_megakernel, dim3(grid_blocks), dim3(512), args, LDS_BYTES, stream);
    if (e != hipSuccess) fprintf(stderr, "cooperative launch failed: %s (grid %d)\n", hipGetErrorString(e), grid_blocks);
}
```

```cpp
#include <hip/hip_runtime.h>
#include <hip/hip_cooperative_groups.h>
#include <cstdio>
#include <cstdint>
namespace cg = cooperative_groups;
__device__ __forceinline__ int hw_lane_id() { return (int)__builtin_amdgcn_mbcnt_hi(~0u, __builtin_amdgcn_mbcnt_lo(~0u, 0u)); }

constexpr int DM = 1024, BATCH = 8, SEQ = 8192, DEPTH = 4, MTOK = BATCH * SEQ;
constexpr int D_IN = 3488, N1 = 1536, NGATE = 2048, QL = 384, KVL = 256, NQB = 768, NKVB = 1024, DFF = 4096;
constexpr float EPS = 1e-5f;
constexpr float LOG2E = 1.4426950408889634f;
constexpr float QA_SCALE = 0.125f * LOG2E;
constexpr float QB_SCALE = 0.10206207261596577f * LOG2E;

__constant__ float INV_FREQ[16] = {1.0f, 0.5623413324356079f, 0.3162277638912201f, 0.17782793939113617f, 0.10000000149011612f, 0.05623413249850273f, 0.03162277489900589f, 0.017782794311642647f,
    0.009999999776482582f, 0.005623413249850273f, 0.003162277629598975f, 0.0017782794311642647f, 0.0010000000474974513f, 0.000562341301701963f, 0.0003162277571391314f, 0.00017782794020604342f};

namespace pg8 {
#define PG8_LAS __attribute__((address_space(3)))
typedef unsigned short bf16_t;
typedef short bf16x8 __attribute__((ext_vector_type(8)));
typedef float f32x4 __attribute__((ext_vector_type(4)));
typedef unsigned u32x4 __attribute__((ext_vector_type(4)));
constexpr int BM = 256, BK = 64, HALF = 128, HTB = HALF * BK * 2  , STAGE_BYTES = 8 * HTB, NXCD = 8, WGM = 8;

__host__ __device__ __forceinline__ int lds_byte(int r, int c) { const int st = (r >> 4) * 2 + (c >> 5), rr = r & 15, cc = c & 31, ob = rr * 64 + cc * 2; return st * 1024 + (ob ^ (((ob >> 9) & 1) << 5)); }
__host__ __device__ __forceinline__ void stage_rc(int b, int& R, int& C) { const int st = b / 1024, sb = b % 1024, swz = sb ^ (((sb >> 9) & 1) << 5); R = (st >> 1) * 16 + swz / 64; C = (st & 1) * 32 + (swz % 64) / 2; }
__host__ __device__ __forceinline__ int perm32(int rho) { const int n = rho >> 4, i = rho & 15; return 8 * (i >> 2) + 4 * n + (i & 3); }

struct Unit { int pm, pn; };
struct Gemm { const bf16_t* A; const bf16_t* Bt; int M, N, K, lda; };

struct StaticOrder {
    int nM, nN, nwg, G, c, flip;
    __host__ __device__ void init(int M, int N, int G_, int c_) { nM = M / BM; nN = N / BM; nwg = nM * nN; G = G_; c = c_; flip = 0; }
    __host__ __device__ bool next(int i, Unit& u) const {
        const long L = (long)i * G + c; if (L >= nwg) return false;
        int wgid = (int)L; { const int q = nwg / NXCD, r = nwg % NXCD, xcd = wgid % NXCD, off = wgid / NXCD; wgid = (xcd < r ? xcd * (q + 1) : r * (q + 1) + (xcd - r) * q) + off; }
        const int nig = WGM * nN, gid = wgid / nig, fm = gid * WGM;
        u.pm = fm + ((wgid % nig) % WGM); u.pn = (wgid % nig) / WGM; if (flip) u.pm = (u.pm & ~31) | (31 - (u.pm & 31)); return true;
    }
    __device__ __forceinline__ void a_ready(const Unit&) const {}
    __device__ __forceinline__ void done(const Unit&) const {}
};


__device__ __forceinline__ unsigned pk_bf16(float lo, float hi) { typedef float f2_t __attribute__((ext_vector_type(2))); typedef __bf16 b2_t __attribute__((ext_vector_type(2))); f2_t v = {lo, hi}; b2_t b = __builtin_convertvector(v, b2_t); return __builtin_bit_cast(unsigned, b); }
__device__ __forceinline__ float bf_lo(unsigned u) { return __builtin_bit_cast(float, u << 16); }
__device__ __forceinline__ float bf_hi(unsigned u) { return __builtin_bit_cast(float, u & 0xffff0000u); }
__device__ __forceinline__ float sigmoidf_(float x) { return __builtin_amdgcn_rcpf(1.0f + __builtin_amdgcn_exp2f(-1.4426950408889634f * x)); }
__device__ __forceinline__ int vperm16(int s) { return (s & 3) + ((s >> 3) & 1) * 4 + ((s >> 2) & 1) * 8; }

enum { EP_PLAIN = 0, EP_RELU2 = 1, EP_Z1 = 2, EP_QB = 3, EP_KVB = 4, EP_GATE = 5, EP_RESID = 6 };
struct Epi {
    static constexpr bool PERM = true, AFTER_DRAIN = false;
    int mode;
    bf16_t* O; int ldc;
    bf16_t* O2;
    bf16_t* O3;
    const bf16_t* Y1; const bf16_t* Y2;
    const float* cs;
    const float* base; float* outf;
    const float* rs; int rs_ld, rs_off, rs_n; float rs_inv;
    float* ss_out;
    bf16_t* xb;
    __device__ __forceinline__ void store8(bf16_t* p, f32x4 v0, f32x4 v1) const {
        u32x4 w; w.x = pk_bf16(v0[0], v0[1]); w.y = pk_bf16(v0[2], v0[3]); w.z = pk_bf16(v1[0], v1[1]); w.w = pk_bf16(v1[2], v1[3]); *(u32x4*)p = w; }
    __device__ __forceinline__ void storeT(bf16_t* vt  , int d0, int s, f32x4 v0, f32x4 v1) const {
        const int pos = (s & ~15) + vperm16(s & 15);
#pragma unroll
        for (int e = 0; e < 4; ++e) { vt[(size_t)(d0 + e) * SEQ + pos] = (bf16_t)(pk_bf16(v0[e], 0.f) & 0xffffu); vt[(size_t)(d0 + 4 + e) * SEQ + pos] = (bf16_t)(pk_bf16(v1[e], 0.f) & 0xffffu); }
    }
    __device__ __forceinline__ void rope8(f32x4& v0, f32x4& v1, const f32x4 (&c)[4], int fq) const {
        const float sg = (fq < 2) ? -1.f : 1.f;
#pragma unroll
        for (int e = 0; e < 4; ++e) {
            const float p0 = __shfl_xor(v0[e], 32), p1 = __shfl_xor(v1[e], 32);
            v0[e] = v0[e] * c[0][e] + sg * p0 * c[2][e]; v1[e] = v1[e] * c[1][e] + sg * p1 * c[3][e];
        }
    }
    __device__ __forceinline__ void operator()(const f32x4 (&acc)[2][2][4][2], const Unit& u, int wr, int wc, int fr, int fq) const {
        const int row0 = u.pm * BM + wr * 64 + fr;
        float rsc[2][4];
        if (rs_n > 0) {
            f32x4 part[2][4];
#pragma unroll
            for (int ai = 0; ai < 2; ++ai)
#pragma unroll
                for (int m = 0; m < 4; ++m) {
                    part[ai][m] = (f32x4){0.f, 0.f, 0.f, 0.f};
                    if (4 * fq < rs_n) part[ai][m] = *(const f32x4*)(rs + (size_t)(row0 + ai * HALF + m * 16) * rs_ld + rs_off + 4 * fq);
                }
#pragma unroll
            for (int ai = 0; ai < 2; ++ai)
#pragma unroll
                for (int m = 0; m < 4; ++m) {
                    float t = (part[ai][m][0] + part[ai][m][1]) + (part[ai][m][2] + part[ai][m][3]);
                    t += __shfl_xor(t, 16); t += __shfl_xor(t, 32);
                    rsc[ai][m] = __builtin_amdgcn_rsqf(t * rs_inv + EPS);
                }
        } else {
#pragma unroll
            for (int ai = 0; ai < 2; ++ai)
#pragma unroll
                for (int m = 0; m < 4; ++m) rsc[ai][m] = 1.0f;
        }
        const int grp0 = u.pn * 8 + wc;
        const bool rope0 = (mode == EP_QB) && (grp0 % 3 == 2), rope1 = (mode == EP_QB) ? ((grp0 + 4) % 3 == 2) : (mode == EP_Z1 && grp0 + 4 == 44);
        u32x4 yall[2][4][2];
#pragma unroll
        for (int aim = 0; aim < 4; ++aim) {
            const int ai = aim >> 1, mb = (aim & 1) * 2;
            if ((aim & 1) == 0) {
                if (mode == EP_GATE) {
#pragma unroll
                    for (int m = 0; m < 4; ++m) { const size_t off = (size_t)(row0 + ai * HALF + m * 16) * DM + u.pn * 128 + wc * 32 + 8 * fq; yall[ai][m][0] = *(const u32x4*)(Y1 + off); yall[ai][m][1] = *(const u32x4*)(Y2 + off); }
                }
                if (mode == EP_RESID) {
#pragma unroll
                    for (int m = 0; m < 4; ++m)
#pragma unroll
                        for (int bj = 0; bj < 2; ++bj) yall[ai][m][bj] = *(const u32x4*)(xb + (size_t)(row0 + ai * HALF + m * 16) * DM + u.pn * BM + bj * HALF + wc * 32 + 8 * fq);
                }
            }
            f32x4 cst[4][4];
            if (rope0 || rope1) {
#pragma unroll
                for (int m = mb; m < mb + 2; ++m) { const float* c = cs + (size_t)(row0 + ai * HALF + m * 16) * 32 + 8 * (fq & 1);
                    cst[m][0] = *(const f32x4*)c; cst[m][1] = *(const f32x4*)(c + 4); cst[m][2] = *(const f32x4*)(c + 16); cst[m][3] = *(const f32x4*)(c + 20); }
            }
#pragma unroll
            for (int m = mb; m < mb + 2; ++m) {
                const int row = row0 + ai * HALF + m * 16;
                const float rs1 = rsc[ai][m];
                if (mode == EP_GATE) {
                    const size_t off = (size_t)row * DM + u.pn * 128 + wc * 32 + 8 * fq;
                    const f32x4 a0 = acc[ai][0][m][0] * rs1, a1 = acc[ai][0][m][1] * rs1, b0 = acc[ai][1][m][0] * rs1, b1 = acc[ai][1][m][1] * rs1;
                    const u32x4 y1 = yall[ai][m][0], y2 = yall[ai][m][1];
                    f32x4 r0, r1;
                    r0[0] = sigmoidf_(a0[0]) * bf_lo(y1.x) + sigmoidf_(b0[0]) * bf_lo(y2.x); r0[1] = sigmoidf_(a0[1]) * bf_hi(y1.x) + sigmoidf_(b0[1]) * bf_hi(y2.x);
                    r0[2] = sigmoidf_(a0[2]) * bf_lo(y1.y) + sigmoidf_(b0[2]) * bf_lo(y2.y); r0[3] = sigmoidf_(a0[3]) * bf_hi(y1.y) + sigmoidf_(b0[3]) * bf_hi(y2.y);
                    r1[0] = sigmoidf_(a1[0]) * bf_lo(y1.z) + sigmoidf_(b1[0]) * bf_lo(y2.z); r1[1] = sigmoidf_(a1[1]) * bf_hi(y1.z) + sigmoidf_(b1[1]) * bf_hi(y2.z);
                    r1[2] = sigmoidf_(a1[2]) * bf_lo(y1.w) + sigmoidf_(b1[2]) * bf_lo(y2.w); r1[3] = sigmoidf_(a1[3]) * bf_hi(y1.w) + sigmoidf_(b1[3]) * bf_hi(y2.w);
                    store8(O + off, r0, r1);
                    continue;
                }
                float ssacc = 0.f;
#pragma unroll
                for (int bj = 0; bj < 2; ++bj) {
                    const int col8 = u.pn * BM + bj * HALF + wc * 32 + 8 * fq;
                    f32x4 v0 = acc[ai][bj][m][0] * rs1, v1 = acc[ai][bj][m][1] * rs1;
                    if (mode == EP_PLAIN) { store8(O + (size_t)row * ldc + col8, v0, v1); }
                    else if (mode == EP_RELU2) {
#pragma unroll
                        for (int e = 0; e < 4; ++e) { float a = fmaxf(v0[e], 0.f), b = fmaxf(v1[e], 0.f); v0[e] = a * a; v1[e] = b * b; }
                        store8(O + (size_t)row * ldc + col8, v0, v1);
                    } else if (mode == EP_Z1) {
                        const int grp = grp0 + bj * 4;
                        if (grp >= 20 && grp < 24) {
                            const int b = row / SEQ, s = row % SEQ, kvh = wc >> 1;
                            storeT(O2 + (size_t)(b * 2 + kvh) * 64 * SEQ, (wc & 1) * 32 + 8 * fq, s, v0, v1);
                        } else if (grp == 44) {
                            rope8(v0, v1, cst[m], fq);
                            bf16_t* kr = O3 + (size_t)row * NQB + 64 + 8 * fq;
#pragma unroll
                            for (int h = 0; h < 8; ++h) store8(kr + h * 96, v0, v1);
                        } else if (grp < 44) {
                            if (grp < 16) { v0 = v0 * QA_SCALE; v1 = v1 * QA_SCALE; }
                            store8(O + (size_t)row * ldc + col8, v0, v1);
                            if (grp >= 24) {
                                float q = (v0[0] * v0[0] + v0[1] * v0[1]) + (v0[2] * v0[2] + v0[3] * v0[3]) + (v1[0] * v1[0] + v1[1] * v1[1]) + (v1[2] * v1[2] + v1[3] * v1[3]);
                                q += __shfl_xor(q, 16); q += __shfl_xor(q, 32);
                                if (fq == 0) ss_out[(size_t)row * 32 + grp - 24] = q;
                            }
                        }
                    } else if (mode == EP_QB) {
                        if (bj == 0 ? rope0 : rope1) rope8(v0, v1, cst[m], fq);
                        v0 = v0 * QB_SCALE; v1 = v1 * QB_SCALE;
                        store8(O + (size_t)row * ldc + col8, v0, v1);
                    } else if (mode == EP_KVB) {
                        const int head = u.pn * 2 + bj;
                        if (wc < 2) store8(O2 + (size_t)row * NQB + head * 96 + wc * 32 + 8 * fq, v0, v1);
                        else { const int b = row / SEQ, s = row % SEQ; storeT(O3 + (size_t)(b * 8 + head) * 64 * SEQ, (wc - 2) * 32 + 8 * fq, s, v0, v1); }
                    } else {
                        const size_t off = (size_t)row * DM + col8;
                        const u32x4 xi = yall[ai][m][bj];
                        const f32x4 x0 = (f32x4){bf_lo(xi.x), bf_hi(xi.x), bf_lo(xi.y), bf_hi(xi.y)} + v0, x1 = (f32x4){bf_lo(xi.z), bf_hi(xi.z), bf_lo(xi.w), bf_hi(xi.w)} + v1;
                        store8(xb + off, x0, x1);
                        ssacc += (x0[0] * x0[0] + x0[1] * x0[1]) + (x0[2] * x0[2] + x0[3] * x0[3]) + (x1[0] * x1[0] + x1[1] * x1[1]) + (x1[2] * x1[2] + x1[3] * x1[3]);
                    }
                }
                if (mode == EP_RESID) {
                    ssacc += __shfl_xor(ssacc, 16); ssacc += __shfl_xor(ssacc, 32);
                    if (fq == 0) ss_out[(size_t)row * 16 + u.pn * 4 + wc] = ssacc;
                }
            }
        }
    }
};
template <class Epi, class Sched, bool ALIGN_EPI = false, bool SP2 = false>
__device__ __forceinline__ void gemm_phase(PG8_LAS unsigned char* lds, const Gemm g, const Sched& S, const Epi& E, int wv) {
    int tid_ = wv * 64 + hw_lane_id(); asm volatile("" : "+v"(tid_));
    const int tid = tid_, wid = __builtin_amdgcn_readfirstlane(tid >> 6), lane = tid & 63, wr = wid >> 2, wc = wid & 3, fr = lane & 15, fq = lane >> 4;
    const int K = g.K, nt = K / BK;
    unsigned voffA[2], voffB[2];
#pragma unroll
    for (int i = 0; i < 2; ++i) { int R, C; stage_rc(tid * 16 + i * 8192, R, C); const int Rb = Epi::PERM ? ((R & ~31) + perm32(R & 31)) : R;
        voffA[i] = (unsigned)(R * g.lda + C) * 2u; voffB[i] = (unsigned)(Rb * K + C) * 2u; }
    const size_t kstep = (size_t)(BK * 2);
    const size_t hstep = (size_t)HALF * K * 2, hstepA = (size_t)HALF * g.lda * 2;
    const size_t tstep = 2 * hstep, tstepA = 2 * hstepA;
    const unsigned ldsw = (unsigned)wid * 1024u;
    const int aoff = lds_byte(wr * 64 + fr, fq * 8), boff = lds_byte(wc * 32 + fr, fq * 8);
#define PG8_SA(b, h) (((b) * 2 + (h)) * HTB)
#define PG8_SB(b, h) ((4 + (b) * 2 + (h)) * HTB)
#define PG8_STAGE(bufoff, gbase, voff) do { _Pragma("unroll") for (int _i = 0; _i < 2; ++_i) \
        __builtin_amdgcn_global_load_lds((const unsigned*)((const char*)(gbase) + (voff)[_i]), (PG8_LAS unsigned*)(lds + (bufoff) + ldsw + _i * 8192), 16, 0, 0); } while (0)
#define PG8_LDA(dst, b, h) do { _Pragma("unroll") for (int m = 0; m < 4; ++m) _Pragma("unroll") for (int k = 0; k < 2; ++k) dst[m][k] = *(const PG8_LAS bf16x8*)(lds + PG8_SA(b, h) + aoff + m * 2048 + k * 1024); } while (0)
#define PG8_LDB(dst, b, h) do { _Pragma("unroll") for (int n = 0; n < 2; ++n) _Pragma("unroll") for (int k = 0; k < 2; ++k) dst[n][k] = *(const PG8_LAS bf16x8*)(lds + PG8_SB(b, h) + boff + n * 2048 + k * 1024); } while (0)
#define PG8_MMA(ai, bj, At, Bt) do { __builtin_amdgcn_s_setprio(1); _Pragma("unroll") for (int m = 0; m < 4; ++m) _Pragma("unroll") for (int n = 0; n < 2; ++n) _Pragma("unroll") for (int k = 0; k < 2; ++k) \
        acc[ai][bj][m][n] = __builtin_amdgcn_mfma_f32_16x16x32_bf16(Bt[n][k], At[m][k], acc[ai][bj][m][n], 0, 0, 0); __builtin_amdgcn_s_setprio(0); } while (0)
#define PG8_WAIT_V(n) asm volatile("s_waitcnt vmcnt(" #n ")" ::: "memory")
#define PG8_WAIT_L(n) asm volatile("s_waitcnt lgkmcnt(" #n ")" ::: "memory")
#define PG8_BAR __builtin_amdgcn_s_barrier()
#define PG8_SCHED __builtin_amdgcn_sched_barrier(0)
    Unit cur, nxt; int ui = 0;
    if (!S.next(0, cur)) return;
    f32x4 acc[2][2][4][2];
#pragma unroll
    for (int a = 0; a < 2; ++a)
#pragma unroll
        for (int b = 0; b < 2; ++b)
#pragma unroll
            for (int m = 0; m < 4; ++m)
#pragma unroll
                for (int n = 0; n < 2; ++n) acc[a][b][m][n] = (f32x4){0.f, 0.f, 0.f, 0.f};
    bf16x8 At[4][2], B0[2][2], B1[2][2];
    const char* cA = (const char*)g.A + (size_t)cur.pm * tstepA; const char* cB = (const char*)g.Bt + (size_t)cur.pn * tstep;
    S.a_ready(cur);
    if constexpr (SP2) {
        PG8_STAGE(PG8_SB(0, 0), cB, voffB); PG8_STAGE(PG8_SB(0, 1), cB + hstep, voffB); PG8_STAGE(PG8_SA(0, 0), cA, voffA); PG8_STAGE(PG8_SA(0, 1), cA + hstepA, voffA);
        if (wr == 1) PG8_BAR;
        PG8_WAIT_V(2); PG8_BAR;
        PG8_STAGE(PG8_SB(1, 0), cB + kstep, voffB); PG8_STAGE(PG8_SA(1, 0), cA + kstep, voffA); PG8_STAGE(PG8_SB(1, 1), cB + hstep + kstep, voffB);
        PG8_WAIT_V(6); PG8_BAR;
    } else {
        PG8_STAGE(PG8_SB(0, 0), cB, voffB); PG8_STAGE(PG8_SA(0, 0), cA, voffA); PG8_STAGE(PG8_SB(0, 1), cB + hstep, voffB); PG8_STAGE(PG8_SA(0, 1), cA + hstepA, voffA);
        if (wr == 1) PG8_BAR;
        PG8_WAIT_V(4); PG8_BAR;
        PG8_STAGE(PG8_SB(1, 0), cB + kstep, voffB); PG8_STAGE(PG8_SA(1, 0), cA + kstep, voffA); PG8_STAGE(PG8_SB(1, 1), cB + hstep + kstep, voffB);
        PG8_WAIT_V(6); PG8_BAR;
    }
    for (;;) {
        const bool has_next = S.next(ui + 1, nxt);
        const char* nA = has_next ? (const char*)g.A + (size_t)nxt.pm * tstepA : cA; const char* nB = has_next ? (const char*)g.Bt + (size_t)nxt.pn * tstep : cB;
        for (int t = 0; t < nt; t += 2) {
            const bool last = (t == nt - 2);
            const char* a1 = cA + (size_t)(t + 1) * kstep;
            const char* a2 = last ? nA : cA + (size_t)(t + 2) * kstep; const char* b2 = last ? nB : cB + (size_t)(t + 2) * kstep;
            const char* a3 = a2 + kstep; const char* b3 = b2 + kstep;
            if (last && has_next) S.a_ready(nxt);
            if constexpr (SP2) {
            PG8_LDB(B0, 0, 0); PG8_LDB(B1, 0, 1); PG8_SCHED; PG8_LDA(At, 0, 0); PG8_STAGE(PG8_SA(1, 1), a1 + hstepA, voffA);
            PG8_WAIT_V(8); PG8_WAIT_L(0); PG8_BAR; PG8_MMA(0, 0, At, B0); PG8_MMA(0, 1, At, B1); PG8_BAR; PG8_SCHED;
            PG8_LDA(At, 0, 1); PG8_STAGE(PG8_SB(0, 0), b2, voffB); PG8_STAGE(PG8_SB(0, 1), b2 + hstep, voffB); PG8_STAGE(PG8_SA(0, 0), a2, voffA);
            PG8_WAIT_V(8); PG8_WAIT_L(0); PG8_BAR; PG8_MMA(1, 0, At, B0); PG8_MMA(1, 1, At, B1); PG8_BAR; PG8_SCHED;
            PG8_LDB(B0, 1, 0); PG8_LDB(B1, 1, 1); PG8_SCHED; PG8_LDA(At, 1, 0); PG8_STAGE(PG8_SA(0, 1), a2 + hstepA, voffA);
            PG8_WAIT_V(8); PG8_WAIT_L(0); PG8_BAR; PG8_MMA(0, 0, At, B0); PG8_MMA(0, 1, At, B1); PG8_BAR; PG8_SCHED;
            PG8_LDA(At, 1, 1); PG8_STAGE(PG8_SB(1, 0), b3, voffB); PG8_STAGE(PG8_SB(1, 1), b3 + hstep, voffB); PG8_STAGE(PG8_SA(1, 0), a3, voffA);
            PG8_WAIT_V(8); PG8_WAIT_L(0); PG8_BAR; PG8_MMA(1, 0, At, B0); PG8_MMA(1, 1, At, B1); PG8_BAR; PG8_SCHED;
            } else {
            PG8_LDB(B0, 0, 0); PG8_SCHED; PG8_LDA(At, 0, 0); PG8_STAGE(PG8_SA(1, 1), a1 + hstepA, voffA);
            PG8_WAIT_L(8); PG8_BAR; PG8_WAIT_L(0); PG8_MMA(0, 0, At, B0); PG8_BAR; PG8_SCHED;
            PG8_LDB(B1, 0, 1); PG8_STAGE(PG8_SB(0, 0), b2, voffB);
            PG8_BAR; PG8_WAIT_L(0); PG8_MMA(0, 1, At, B1); PG8_BAR;
            PG8_LDA(At, 0, 1); PG8_STAGE(PG8_SA(0, 0), a2, voffA);
            PG8_BAR; PG8_WAIT_L(0); PG8_MMA(1, 0, At, B0); PG8_BAR; PG8_SCHED;
            PG8_STAGE(PG8_SB(0, 1), b2 + hstep, voffB);
            PG8_WAIT_V(6); PG8_BAR; PG8_MMA(1, 1, At, B1); PG8_BAR;
            PG8_LDB(B0, 1, 0); PG8_SCHED; PG8_LDA(At, 1, 0); PG8_STAGE(PG8_SA(0, 1), a2 + hstepA, voffA);
            PG8_WAIT_L(8); PG8_BAR; PG8_WAIT_L(0); PG8_MMA(0, 0, At, B0); PG8_BAR; PG8_SCHED;
            PG8_LDB(B1, 1, 1); PG8_STAGE(PG8_SB(1, 0), b3, voffB);
            PG8_BAR; PG8_WAIT_L(0); PG8_MMA(0, 1, At, B1); PG8_BAR;
            PG8_LDA(At, 1, 1); PG8_STAGE(PG8_SA(1, 0), a3, voffA);
            PG8_BAR; PG8_WAIT_L(0); PG8_MMA(1, 0, At, B0); PG8_BAR; PG8_SCHED;
            PG8_STAGE(PG8_SB(1, 1), b3 + hstep, voffB);
            PG8_WAIT_V(6); PG8_BAR; PG8_MMA(1, 1, At, B1); PG8_BAR;
            }
        }
        if constexpr (ALIGN_EPI) { if (wr == 0) PG8_BAR; }
        if constexpr (!Epi::AFTER_DRAIN) { E(acc, cur, wr, wc, fr, fq); S.done(cur); }
        if (!has_next) break;
#pragma unroll
        for (int a = 0; a < 2; ++a)
#pragma unroll
            for (int b = 0; b < 2; ++b)
#pragma unroll
                for (int m = 0; m < 4; ++m)
#pragma unroll
                    for (int n = 0; n < 2; ++n) acc[a][b][m][n] = (f32x4){0.f, 0.f, 0.f, 0.f};
        cur = nxt; cA = nA; cB = nB; ++ui;
        if constexpr (ALIGN_EPI) { if (wr == 1) PG8_BAR; }
    }
    PG8_WAIT_V(0);
    if constexpr (!ALIGN_EPI) { if (wr == 0) PG8_BAR; }
    PG8_BAR;
    if constexpr (Epi::AFTER_DRAIN) { E.fused(acc, cur, wr, wc, fr, fq, lds, wid, lane); S.done(cur); }
#undef PG8_SA
#undef PG8_SB
#undef PG8_STAGE
#undef PG8_LDA
#undef PG8_LDB
#undef PG8_MMA
#undef PG8_WAIT_V
#undef PG8_WAIT_L
#undef PG8_BAR
#undef PG8_SCHED
}
}
#define LAS __attribute__((address_space(3)))
using namespace pg8;
typedef float f32x16 __attribute__((ext_vector_type(16)));
#define MFMA32(a, b, c) __builtin_amdgcn_mfma_f32_32x32x16_bf16((a), (b), (c), 0, 0, 0)

constexpr size_t MiB = 1u << 20;
constexpr size_t WS_CTL = 0;
constexpr size_t WS_W = 1 * MiB, W_LAYER = 29 * MiB;
constexpr size_t WO_IN1 = 0, WO_G = 3 * MiB, WO_UQ = 7 * MiB, WO_UKV = 8 * MiB, WO_A = 9 * MiB, WO_B = 10 * MiB, WO_OUT = 11 * MiB, WO_FF1 = 13 * MiB, WO_FF2 = 21 * MiB;
constexpr size_t WS_CS = WS_W + DEPTH * W_LAYER;
constexpr size_t WS_H = WS_CS + 8 * MiB;
constexpr size_t WS_BIG = WS_H + 128 * MiB;
constexpr size_t B_Z1 = 0, B_CQN = 192 * MiB, B_CKVN = 240 * MiB, B_QB = 272 * MiB, B_KB = 368 * MiB, B_VT = 464 * MiB, B_OA = 192 * MiB, B_OB = 528 * MiB, B_VTA = 592 * MiB;
constexpr size_t B_YA = 0, B_YB = 272 * MiB, B_MERGED = 400 * MiB, B_HID = 0;
constexpr size_t WS_SS = WS_BIG + 608 * MiB;
constexpr size_t WS_SSL = WS_SS + 4 * MiB;
constexpr size_t WS_END = WS_SSL + 8 * MiB;
constexpr int LDS_BYTES = 131072 + 64;
constexpr size_t WS_BAR = 65536;

struct Params { const float* in[17]; float* out; unsigned char* ws; };

__device__ __forceinline__ float wave_sum(float v) {
#pragma unroll
    for (int o = 1; o < 64; o <<= 1) v += __shfl_xor(v, o);
    return v;
}

__device__ __forceinline__ void transpose_matrix(const float* W, int ldw, int K, int N, int cmap, const float* gk, bf16_t* WT, LAS unsigned* img, int tid, int vb, int nvb) {
    const int lane = tid & 63, w = tid >> 6;
    const int nblk = N / 256, items = (K / 64) * nblk;
    for (int it = vb; it < items; it += nvb) {
        const int kb = it / nblk, nb = it % nblk, n0 = nb * 256, k0 = kb * 64 + w * 8;
        float v[4][4][2];
#pragma unroll
        for (int j = 0; j < 4; ++j) {
            const int nn = n0 + 64 * j;
            int c0 = nn;
            if (cmap == 1) c0 = nn; else if (cmap == 2) c0 = 1440 + ((nn & 255) >> 7) * 1024 + (nn >> 8) * 128 + (nn & 127);
            const bool ok = (cmap != 1) || (nn + lane < 1440);
#pragma unroll
            for (int kp = 0; kp < 4; ++kp)
#pragma unroll
                for (int e = 0; e < 2; ++e) v[j][kp][e] = ok ? W[(size_t)(k0 + 2 * kp + e) * ldw + c0 + lane] : 0.f;
        }
        float g[8];
#pragma unroll
        for (int i = 0; i < 8; ++i) g[i] = gk ? gk[k0 + i] : 1.f;
        __syncthreads();
#pragma unroll
        for (int j = 0; j < 4; ++j)
#pragma unroll
            for (int kp = 0; kp < 4; ++kp) img[(64 * j + lane) * 33 + w * 4 + kp] = pk_bf16(v[j][kp][0] * g[2 * kp], v[j][kp][1] * g[2 * kp + 1]);
        __syncthreads();
#pragma unroll
        for (int i = 0; i < 4; ++i) {
            const int n = (tid >> 3) + 64 * i, c = tid & 7;
            const LAS unsigned* q = img + n * 33 + c * 4;
            u32x4 o; o.x = q[0]; o.y = q[1]; o.z = q[2]; o.w = q[3];
            *(u32x4*)(WT + (size_t)(n0 + n) * K + kb * 64 + c * 8) = o;
        }
    }
}

__device__ __forceinline__ void rms_row_bf16(const float* xrow, const float* g, bf16_t* orow, int lane) {
    const f32x4* xr = (const f32x4*)xrow + lane; const f32x4* gr = (const f32x4*)g + lane;
    f32x4 v[4]; float s = 0.f;
#pragma unroll
    for (int j = 0; j < 4; ++j) { v[j] = xr[64 * j]; s += (v[j].x * v[j].x + v[j].y * v[j].y) + (v[j].z * v[j].z + v[j].w * v[j].w); }
    const float rstd = __builtin_amdgcn_rsqf(wave_sum(s) * (1.f / DM) + EPS);
    unsigned long long* o8 = (unsigned long long*)orow + lane;
#pragma unroll
    for (int j = 0; j < 4; ++j) { const f32x4 gg = gr[64 * j];
        o8[64 * j] = (unsigned long long)pk_bf16(v[j].x * rstd * gg.x, v[j].y * rstd * gg.y) | ((unsigned long long)pk_bf16(v[j].z * rstd * gg.z, v[j].w * rstd * gg.w) << 32); }
}
__device__ __forceinline__ void final_rows2(const bf16_t* XB, const float* SS, const float* g, float* out, int row0, int row1, int lane) {
    const int rows[2] = {row0, row1};
    f32x4 pp[2][4]; u32x4 xi[2][2];
#pragma unroll
    for (int q = 0; q < 2; ++q) { const float* ss = SS + (size_t)rows[q] * 16;
#pragma unroll
        for (int i = 0; i < 4; ++i) pp[q][i] = *(const f32x4*)(ss + 4 * i);
        const u32x4* xr = (const u32x4*)(XB + (size_t)rows[q] * DM) + lane;
        xi[q][0] = xr[0]; xi[q][1] = xr[64]; }
    const f32x4* gr = (const f32x4*)g + 2 * lane;
    const f32x4 g00 = gr[0], g01 = gr[1], g10 = gr[128], g11 = gr[129];
#pragma unroll
    for (int q = 0; q < 2; ++q) {
        float t = 0.f;
#pragma unroll
        for (int i = 0; i < 4; ++i) t += (pp[q][i][0] + pp[q][i][1]) + (pp[q][i][2] + pp[q][i][3]);
        const float rstd = __builtin_amdgcn_rsqf(t * (1.f / DM) + EPS);
        f32x4* o = (f32x4*)(out + (size_t)rows[q] * DM) + 2 * lane;
        const u32x4 a = xi[q][0], b = xi[q][1];
        o[0] = (f32x4){bf_lo(a.x), bf_hi(a.x), bf_lo(a.y), bf_hi(a.y)} * rstd * g00; o[1] = (f32x4){bf_lo(a.z), bf_hi(a.z), bf_lo(a.w), bf_hi(a.w)} * rstd * g01;
        o[128] = (f32x4){bf_lo(b.x), bf_hi(b.x), bf_lo(b.y), bf_hi(b.y)} * rstd * g10; o[129] = (f32x4){bf_lo(b.z), bf_hi(b.z), bf_lo(b.w), bf_hi(b.w)} * rstd * g11;
    }
}
__device__ __forceinline__ void prologue_rows2(const float* x, const int* positions, bf16_t* XB, float* SS, float* CS, int row0, int row1, int lane) {
    f32x4 v[2][4]; float s[2] = {0.f, 0.f};
    const int rows[2] = {row0, row1};
#pragma unroll
    for (int q = 0; q < 2; ++q) { const f32x4* xr = (const f32x4*)(x + (size_t)rows[q] * DM) + lane;
#pragma unroll
        for (int j = 0; j < 4; ++j) v[q][j] = xr[64 * j]; }
    int pos[2] = {0, 0};
    if (lane < 16) { pos[0] = positions[row0]; pos[1] = positions[row1]; }
#pragma unroll
    for (int q = 0; q < 2; ++q) {
#pragma unroll
        for (int j = 0; j < 4; ++j) s[q] += (v[q][j].x * v[q][j].x + v[q][j].y * v[q][j].y) + (v[q][j].z * v[q][j].z + v[q][j].w * v[q][j].w);
        s[q] = wave_sum(s[q]);
        unsigned long long* o8 = (unsigned long long*)(XB + (size_t)rows[q] * DM) + lane;
#pragma unroll
        for (int j = 0; j < 4; ++j) o8[64 * j] = (unsigned long long)pk_bf16(v[q][j].x, v[q][j].y) | ((unsigned long long)pk_bf16(v[q][j].z, v[q][j].w) << 32);
        if (lane < 16) {
            SS[(size_t)rows[q] * 16 + lane] = (lane == 0) ? s[q] : 0.f;
            const float a = (float)pos[q] * INV_FREQ[lane];
            double t = (double)a * 0.15915494309189535; t -= rint(t);
            const float fr = (float)t;
            CS[(size_t)rows[q] * 32 + lane] = __builtin_amdgcn_cosf(fr); CS[(size_t)rows[q] * 32 + 16 + lane] = __builtin_amdgcn_sinf(fr);
        }
    }
}

__device__ __forceinline__ int crow(int i, int hh) { return (i & 3) + 8 * (i >> 2) + 4 * hh; }
__device__ __forceinline__ bf16x8 pack8(const f32x16& x, int s8) {
    u32x4 p; p.x = pk_bf16(x[s8 + 0], x[s8 + 1]); p.y = pk_bf16(x[s8 + 2], x[s8 + 3]); p.z = pk_bf16(x[s8 + 4], x[s8 + 5]); p.w = pk_bf16(x[s8 + 6], x[s8 + 7]);
    return __builtin_bit_cast(bf16x8, p);
}
__device__ __forceinline__ void xhalf_swap(float x, float& a, float& b) { a = x; b = x; asm volatile("s_nop 1\n\tv_permlane32_swap_b32 %0, %1\n\ts_nop 1" : "+v"(a), "+v"(b)); }
__device__ __forceinline__ float xhalf_max(float x) { float a, b; xhalf_swap(x, a, b); float m; asm("v_max3_f32 %0, %1, %2, %3" : "=v"(m) : "v"(x), "v"(a), "v"(b)); return m; }
__device__ __forceinline__ float xhalf_sum(float x) { float a, b; xhalf_swap(x, a, b); return a + b; }
constexpr float RESCALE_THR = 6.0f;
__device__ __forceinline__ float max3f(float a, float b, float c) { float r; asm("v_max3_f32 %0, %1, %2, %3" : "=v"(r) : "v"(a), "v"(b), "v"(c)); return r; }
__device__ __forceinline__ float max16(const f32x16& x) {
    const float a = max3f(x[0], x[1], x[2]), b = max3f(x[3], x[4], x[5]), c = max3f(x[6], x[7], x[8]), d = max3f(x[9], x[10], x[11]), e = max3f(x[12], x[13], x[14]);
    return max3f(max3f(a, b, c), max3f(d, e, x[15]), x[15]);
}
__device__ __forceinline__ void swap32u(unsigned& a, unsigned& b) { asm volatile("s_nop 1\n\tv_permlane32_swap_b32 %0, %1\n\ts_nop 1" : "+v"(a), "+v"(b)); }
__device__ __forceinline__ void store_ot(bf16_t* orow  , const f32x16& o, int d0, int hh, float inv) {
    unsigned lo[4], hi[4];
#pragma unroll
    for (int g = 0; g < 4; ++g) { lo[g] = pk_bf16(o[4 * g] * inv, o[4 * g + 1] * inv); hi[g] = pk_bf16(o[4 * g + 2] * inv, o[4 * g + 3] * inv); }
#pragma unroll
    for (int k = 0; k < 4; k += 2) {
        swap32u(lo[k], lo[k + 1]); swap32u(hi[k], hi[k + 1]);
        u32x4 w; w.x = lo[k]; w.y = hi[k]; w.z = lo[k + 1]; w.w = hi[k + 1];
        *(u32x4*)(orow + d0 + 8 * (k + hh)) = w;
    }
}

constexpr int MK_ROW = 208, MV_ROW = 144, MK_BYTES = 64 * MK_ROW, MV_BYTES = 64 * MV_ROW, MV_BASE = 2 * MK_BYTES;
__device__ __forceinline__ void mla_qk(f32x16& s0, f32x16& s1, const LAS unsigned char* kb, const bf16x8 (&qf)[6], int r, int hh) {
    bf16x8 ka[6], kc[6];
    const LAS unsigned char* kp = kb + r * MK_ROW + hh * 16;
#pragma unroll
    for (int s = 0; s < 6; ++s) { ka[s] = *(const LAS bf16x8*)(kp + s * 32); kc[s] = *(const LAS bf16x8*)(kp + 32 * MK_ROW + s * 32); }
    __builtin_amdgcn_sched_barrier(0);
#pragma unroll
    for (int i = 0; i < 16; ++i) { s0[i] = 0.f; s1[i] = 0.f; }
#pragma unroll
    for (int s = 0; s < 6; ++s) { s0 = MFMA32(ka[s], qf[s], s0); s1 = MFMA32(kc[s], qf[s], s1); }
}
__device__ __forceinline__ void mla_sm_pv(f32x16& s0, f32x16& s1, f32x16& o0, f32x16& o1, float& m, float& l, const LAS unsigned char* vbuf, int k0, int q0, int r, int hh) {
    bf16x8 va[4], vc[4];
    const LAS unsigned char* vb = vbuf + r * MV_ROW + hh * 16;
#pragma unroll
    for (int ks = 0; ks < 4; ++ks) { va[ks] = *(const LAS bf16x8*)(vb + ks * 32); vc[ks] = *(const LAS bf16x8*)(vb + 32 * MV_ROW + ks * 32); }
    __builtin_amdgcn_sched_barrier(0);
    if (k0 + 63 > q0) {
        const int qpos = q0 + r;
#pragma unroll
        for (int i = 0; i < 16; ++i) { const int kp = k0 + crow(i, hh); if (kp > qpos) s0[i] = -INFINITY; if (kp + 32 > qpos) s1[i] = -INFINITY; }
    }
    float mx = max3f(max16(s0), max16(s1), m); const float mn = max3f(mx, __shfl_xor(mx, 32), mx), alpha = __builtin_amdgcn_exp2f(m - mn); m = mn;
    float ps = 0.f;
#pragma unroll
    for (int i = 0; i < 16; ++i) { s0[i] = __builtin_amdgcn_exp2f(s0[i] - mn); s1[i] = __builtin_amdgcn_exp2f(s1[i] - mn); ps += s0[i] + s1[i]; }
    l = l * alpha + ps;
    if (__any(alpha != 1.0f)) {
#pragma unroll
        for (int i = 0; i < 16; ++i) { o0[i] *= alpha; o1[i] *= alpha; }
    }
#pragma unroll
    for (int ks = 0; ks < 4; ++ks) {
        const bf16x8 pb = (ks < 2) ? pack8(s0, 8 * (ks & 1)) : pack8(s1, 8 * (ks & 1));
        o0 = MFMA32(va[ks], pb, o0); o1 = MFMA32(vc[ks], pb, o1);
    }
}
__device__ __forceinline__ void mla_unit(LAS unsigned char* lds, const bf16_t* QB, const bf16_t* KB, const bf16_t* VT, bf16_t* OB, int b, int h, int qb, int wv) {
    int tid_ = wv * 64 + hw_lane_id(); asm volatile("" : "+v"(tid_));
    const int tid = tid_, lane = tid & 63, wid = __builtin_amdgcn_readfirstlane(tid >> 6), r = lane & 31, hh = lane >> 5;
    const int q0 = qb * 256 + wid * 32;
    const size_t rowbase = (size_t)b * SEQ;
    bf16x8 qf[6];
    { const bf16_t* qp = QB + (rowbase + q0 + r) * NQB + h * 96 + 8 * hh;
#pragma unroll
      for (int s = 0; s < 6; ++s) qf[s] = *(const bf16x8*)(qp + 16 * s); }
    f32x16 o0, o1;
#pragma unroll
    for (int i = 0; i < 16; ++i) { o0[i] = 0.f; o1[i] = 0.f; }
    float m = -INFINITY, l = 0.f;
    const int ntiles = 4 * (qb + 1), nact = (q0 + 31) / 64 + 1;
    const bool grpA = wid < 4;
    const int kA_key = tid / 12, kA_part = tid % 12, kC_key = (512 + (tid & 255)) / 12, kC_part = (512 + (tid & 255)) % 12, v_d = tid >> 3, v_part = tid & 7;
    const bf16_t* gKA = KB + (rowbase + kA_key) * NQB + h * 96 + kA_part * 8;
    const bf16_t* gKC = KB + (rowbase + kC_key) * NQB + h * 96 + kC_part * 8;
    const bf16_t* gV = VT + ((size_t)(b * 8 + h) * 64 + v_d) * SEQ + v_part * 8;
    const int lKA = kA_key * MK_ROW + kA_part * 16, lKC = kC_key * MK_ROW + kC_part * 16, lV = MV_BASE + v_d * MV_ROW + v_part * 16;
    u32x4 ra, rc, rv, ra1, rc1, xa, xc, xv, ya, yc, yv;
    ra = *(const u32x4*)gKA; rv = *(const u32x4*)gV; ra1 = *(const u32x4*)(gKA + (size_t)64 * NQB);
    rc = *(const u32x4*)gKC; rc1 = *(const u32x4*)(gKC + (size_t)64 * NQB);
    ya = *(const u32x4*)(gKA + (size_t)128 * NQB); yv = *(const u32x4*)(gV + 64); yc = *(const u32x4*)(gKC + (size_t)128 * NQB);
    __syncthreads();
    *(LAS u32x4*)(lds + lKA) = ra; *(LAS u32x4*)(lds + lV) = rv; *(LAS u32x4*)(lds + MK_BYTES + lKA) = ra1;
    *(LAS u32x4*)(lds + lKC) = rc; *(LAS u32x4*)(lds + MK_BYTES + lKC) = rc1;
    __syncthreads();
    f32x16 sa0, sa1, sb0, sb1;
    mla_qk(sa0, sa1, lds, qf, r, hh);
    const int tl = ntiles - 1;
#define MLA_ITER(T, C0, C1, N0, N1, RA, RC, RV, WA, WC, WV) do { const int t_ = (T); \
        { const int tk = (t_ + 3 < tl) ? t_ + 3 : tl, tv = (t_ + 2 < tl) ? t_ + 2 : tl; \
          RA = *(const u32x4*)(gKA + (size_t)tk * 64 * NQB); RC = *(const u32x4*)(gKC + (size_t)tk * 64 * NQB); RV = *(const u32x4*)(gV + tv * 64); } \
        if (grpA && t_ + 1 < nact) mla_qk(N0, N1, lds + ((t_ + 1) & 1) * MK_BYTES, qf, r, hh); \
        if (t_ < nact) mla_sm_pv(C0, C1, o0, o1, m, l, lds + MV_BASE + (t_ & 1) * MV_BYTES, t_ * 64, q0, r, hh); \
        if (!grpA && t_ + 1 < nact) mla_qk(N0, N1, lds + ((t_ + 1) & 1) * MK_BYTES, qf, r, hh); \
        *(LAS u32x4*)(lds + (t_ & 1) * MK_BYTES + lKA) = WA; *(LAS u32x4*)(lds + (t_ & 1) * MK_BYTES + lKC) = WC; \
        *(LAS u32x4*)(lds + ((t_ + 1) & 1) * MV_BYTES + lV) = WV; \
        __syncthreads(); } while (0)
#pragma unroll 1
    for (int t = 0; t < ntiles; t += 2) {
        MLA_ITER(t, sa0, sa1, sb0, sb1, xa, xc, xv, ya, yc, yv);
        MLA_ITER(t + 1, sb0, sb1, sa0, sa1, ya, yc, yv, xa, xc, xv);
    }
#undef MLA_ITER
    l += __shfl_xor(l, 32);
    const float inv = 1.0f / l;
    bf16_t* orow = OB + (rowbase + q0 + r) * 512 + h * 64;
    store_ot(orow, o0, 0, hh, inv); store_ot(orow, o1, 32, hh, inv);
}

__device__ __forceinline__ void mla_softmax(f32x16& s0, f32x16& s1, f32x16& o0, f32x16& o1, float& m, float& l, int k0, int qrow0, int r, int hh) {
    if (k0 + 63 > qrow0) {
        const int qpos = qrow0 + r;
#pragma unroll
        for (int i = 0; i < 16; ++i) { const int kp = k0 + crow(i, hh); if (kp > qpos) s0[i] = -INFINITY; if (kp + 32 > qpos) s1[i] = -INFINITY; }
    }
    const float a16 = max16(s0), b16 = max16(s1);
    const float mx = xhalf_max(max3f(a16, b16, b16));
    float alpha = 1.0f;
    if (__any(mx > m + RESCALE_THR)) {
        const float mn = fmaxf(m, mx); alpha = __builtin_amdgcn_exp2f(m - mn); m = mn;
#pragma unroll
        for (int i = 0; i < 16; ++i) { o0[i] *= alpha; o1[i] *= alpha; }
    }
    float ps = 0.f;
#pragma unroll
    for (int i = 0; i < 16; ++i) { s0[i] = __builtin_amdgcn_exp2f(s0[i] - m); s1[i] = __builtin_amdgcn_exp2f(s1[i] - m); ps += s0[i] + s1[i]; }
    l = l * alpha + ps;
}
constexpr int M2BUF = MK_BYTES + MV_BYTES;
__device__ __forceinline__ void mla_unit2(LAS unsigned char* lds, const bf16_t* QB, const bf16_t* KB, const bf16_t* VT, bf16_t* OB, int b, int h, int qb, int wv) {
    int tid_ = wv * 64 + hw_lane_id(); asm volatile("" : "+v"(tid_));
    const int tid = tid_, lane = tid & 63, wid = __builtin_amdgcn_readfirstlane(tid >> 6), r = lane & 31, hh = lane >> 5;
    const int q0 = qb * 512 + wid * 64;
    const size_t rowbase = (size_t)b * SEQ;
    bf16x8 qa[6], qbf[6];
    { const bf16_t* qp = QB + (rowbase + q0 + r) * NQB + h * 96 + 8 * hh;
#pragma unroll
      for (int s = 0; s < 6; ++s) { qa[s] = *(const bf16x8*)(qp + 16 * s); qbf[s] = *(const bf16x8*)(qp + (size_t)32 * NQB + 16 * s); } }
    f32x16 oa0, oa1, ob0, ob1;
#pragma unroll
    for (int i = 0; i < 16; ++i) { oa0[i] = 0.f; oa1[i] = 0.f; ob0[i] = 0.f; ob1[i] = 0.f; }
    float ma = -INFINITY, mb = -INFINITY, la = 0.f, lb = 0.f;
    const int ntiles = 8 * (qb + 1), nact = q0 / 64 + 1, tl = ntiles - 1;
    const int kA_key = tid / 12, kA_part = tid % 12, kC_key = (512 + (tid & 255)) / 12, kC_part = (512 + (tid & 255)) % 12, v_d = tid >> 3, v_part = tid & 7;
    const bf16_t* gKA = KB + (rowbase + kA_key) * NQB + h * 96 + kA_part * 8;
    const bf16_t* gKC = KB + (rowbase + kC_key) * NQB + h * 96 + kC_part * 8;
    const bf16_t* gV = VT + ((size_t)(b * 8 + h) * 64 + v_d) * SEQ + v_part * 8;
    const int lKA = kA_key * MK_ROW + kA_part * 16, lKC = kC_key * MK_ROW + kC_part * 16, lV = MK_BYTES + v_d * MV_ROW + v_part * 16;
    u32x4 ra = *(const u32x4*)gKA, rc = *(const u32x4*)gKC, rv = *(const u32x4*)gV;
    __syncthreads();
    *(LAS u32x4*)(lds + lKA) = ra; *(LAS u32x4*)(lds + lKC) = rc; *(LAS u32x4*)(lds + lV) = rv;
    __syncthreads();
#pragma unroll 1
    for (int t = 0; t < ntiles; ++t) {
        LAS unsigned char* cur = lds + (t & 1) * M2BUF;
        { const int tn = (t + 1 < tl) ? t + 1 : tl;
          ra = *(const u32x4*)(gKA + (size_t)tn * 64 * NQB); rc = *(const u32x4*)(gKC + (size_t)tn * 64 * NQB); rv = *(const u32x4*)(gV + tn * 64); }
        if (t < nact) {
            const int k0 = t * 64;
            f32x16 sa0, sa1, sb0, sb1;
            { const LAS unsigned char* kp = cur + r * MK_ROW + hh * 16;
#pragma unroll
              for (int i = 0; i < 16; ++i) { sa0[i] = 0.f; sa1[i] = 0.f; sb0[i] = 0.f; sb1[i] = 0.f; }
#pragma unroll
              for (int hf = 0; hf < 2; ++hf) {
                  bf16x8 ka[3], kc[3];
#pragma unroll
                  for (int s = 0; s < 3; ++s) { ka[s] = *(const LAS bf16x8*)(kp + (3 * hf + s) * 32); kc[s] = *(const LAS bf16x8*)(kp + 32 * MK_ROW + (3 * hf + s) * 32); }
                  __builtin_amdgcn_sched_barrier(0);
#pragma unroll
                  for (int s = 0; s < 3; ++s) { sa0 = MFMA32(ka[s], qa[3 * hf + s], sa0); sa1 = MFMA32(kc[s], qa[3 * hf + s], sa1); sb0 = MFMA32(ka[s], qbf[3 * hf + s], sb0); sb1 = MFMA32(kc[s], qbf[3 * hf + s], sb1); }
                  __builtin_amdgcn_sched_barrier(0);
              } }
            mla_softmax(sa0, sa1, oa0, oa1, ma, la, k0, q0, r, hh);
            const LAS unsigned char* vb = cur + MK_BYTES + r * MV_ROW + hh * 16;
            mla_softmax(sb0, sb1, ob0, ob1, mb, lb, k0, q0 + 32, r, hh);
            bf16x8 v0 = *(const LAS bf16x8*)vb, v1 = *(const LAS bf16x8*)(vb + 32 * MV_ROW);
#pragma unroll
            for (int ks = 0; ks < 4; ++ks) {
                bf16x8 n0 = v0, n1 = v1;
                if (ks < 3) { n0 = *(const LAS bf16x8*)(vb + (ks + 1) * 32); n1 = *(const LAS bf16x8*)(vb + 32 * MV_ROW + (ks + 1) * 32); }
                const bf16x8 pa = (ks < 2) ? pack8(sa0, 8 * (ks & 1)) : pack8(sa1, 8 * (ks & 1));
                const bf16x8 pb = (ks < 2) ? pack8(sb0, 8 * (ks & 1)) : pack8(sb1, 8 * (ks & 1));
                oa0 = MFMA32(v0, pa, oa0); oa1 = MFMA32(v1, pa, oa1); ob0 = MFMA32(v0, pb, ob0); ob1 = MFMA32(v1, pb, ob1);
                v0 = n0; v1 = n1;
            }
        }
        { LAS unsigned char* nxt = lds + ((t + 1) & 1) * M2BUF;
          *(LAS u32x4*)(nxt + lKA) = ra; *(LAS u32x4*)(nxt + lKC) = rc; *(LAS u32x4*)(nxt + lV) = rv; }
        __syncthreads();
    }
    la = xhalf_sum(la); lb = xhalf_sum(lb);
    const float ia = 1.0f / la, ib = 1.0f / lb;
    bf16_t* orow = OB + (rowbase + q0 + r) * 512 + h * 64;
    store_ot(orow, oa0, 0, hh, ia); store_ot(orow, oa1, 32, hh, ia);
    store_ot(orow + (size_t)32 * 512, ob0, 0, hh, ib); store_ot(orow + (size_t)32 * 512, ob1, 32, hh, ib);
}

constexpr int SK_ROW = 144, SV_ROW = 528, SK_BYTES = 256 * SK_ROW, SV_BYTES = 64 * SV_ROW, S_BIAS = SK_BYTES + SV_BYTES;
__device__ __forceinline__ void swa_unit(LAS unsigned char* lds, const bf16_t* Z1, const bf16_t* VTA, const float* bias2, const float* sinks, bf16_t* OA, int b, int kvh, int qblk, int wv) {
    int tid_ = wv * 64 + hw_lane_id(); asm volatile("" : "+v"(tid_));
    const int tid = tid_, lane = tid & 63, wid = __builtin_amdgcn_readfirstlane(tid >> 6), r = lane & 31, hh = lane >> 5;
    const int Q0 = qblk * 128;
    const size_t rowbase = (size_t)b * SEQ;
    u32x4 kst[4], vst[4];
#pragma unroll
    for (int i = 0; i < 4; ++i) { const int c = tid + 512 * i, key = c >> 3, part = c & 7, kp = Q0 - 128 + key, kq = kp < 0 ? 0 : kp;
        kst[i] = *(const u32x4*)(Z1 + (rowbase + kq) * N1 + 512 + kvh * 64 + part * 8); }
#pragma unroll
    for (int i = 0; i < 4; ++i) { const int c = tid + 512 * i, d = c >> 5, part = c & 31, kp = Q0 - 128 + part * 8, kq = kp < 0 ? 0 : kp;
        vst[i] = *(const u32x4*)(VTA + ((size_t)(b * 2 + kvh) * 64 + d) * SEQ + kq); }
    const float bias_v = bias2[(kvh * 4 + (tid >> 7)) * 128 + (tid & 127)];
    __syncthreads();
#pragma unroll
    for (int i = 0; i < 4; ++i) { const int c = tid + 512 * i, key = c >> 3, part = c & 7, kp = Q0 - 128 + key;
        u32x4 v = kst[i]; if (kp < 0) v = (u32x4){0u, 0u, 0u, 0u};
        *(LAS u32x4*)(lds + key * SK_ROW + part * 16) = v; }
#pragma unroll
    for (int i = 0; i < 4; ++i) { const int c = tid + 512 * i, d = c >> 5, part = c & 31, kp = Q0 - 128 + part * 8;
        u32x4 v = vst[i]; if (kp < 0) v = (u32x4){0u, 0u, 0u, 0u};
        *(LAS u32x4*)(lds + SK_BYTES + d * SV_ROW + part * 16) = v; }
    ((LAS float*)(lds + S_BIAS))[tid] = bias_v;
    __syncthreads();
    const int g = wid & 3, half = wid >> 2, head = kvh * 4 + g;
    const LAS float* bl = (const LAS float*)(lds + S_BIAS) + g * 128;
    const float sink2 = sinks[head] * LOG2E;
#pragma unroll 1
    for (int sub = 0; sub < 2; ++sub) {
        const int q0w = 64 * half + 32 * sub;
        bf16x8 qf[4];
        { const bf16_t* qp = Z1 + (rowbase + Q0 + q0w + r) * N1 + head * 64 + 8 * hh;
#pragma unroll
          for (int s = 0; s < 4; ++s) qf[s] = *(const bf16x8*)(qp + 16 * s); }
        f32x16 o0, o1;
#pragma unroll
        for (int i = 0; i < 16; ++i) { o0[i] = 0.f; o1[i] = 0.f; }
        float m = sink2, l = (hh == 0) ? 1.f : 0.f;
#pragma unroll
        for (int kt = 0; kt < 5; ++kt) {
            const int kb = q0w + 32 * kt;
            if (Q0 == 0 && kb + 31 < 128) continue;
            f32x16 sc;
#pragma unroll
            for (int i = 0; i < 16; ++i) sc[i] = 0.f;
#pragma unroll
            for (int s = 0; s < 4; ++s) { const bf16x8 a = *(const LAS bf16x8*)(lds + (kb + r) * SK_ROW + s * 32 + hh * 16); sc = MFMA32(a, qf[s], sc); }
#pragma unroll
            for (int i = 0; i < 16; ++i) { const int c = crow(i, hh), dist = 128 - 32 * kt + r - c;
                const bool ok = (dist >= 0) && (dist < 128) && (Q0 > 0 || kb + c >= 128);
                sc[i] = ok ? sc[i] + bl[dist & 127] : -INFINITY; }
            const float mx = xhalf_max(max16(sc));
            float alpha = 1.0f;
            if (__any(mx > m + RESCALE_THR)) {
                const float mn = fmaxf(m, mx); alpha = __builtin_amdgcn_exp2f(m - mn); m = mn;
#pragma unroll
                for (int i = 0; i < 16; ++i) { o0[i] *= alpha; o1[i] *= alpha; }
            }
            float ps = 0.f;
#pragma unroll
            for (int i = 0; i < 16; ++i) { sc[i] = __builtin_amdgcn_exp2f(sc[i] - m); ps += sc[i]; }
            l = l * alpha + ps;
            const LAS unsigned char* vb = lds + SK_BYTES + r * SV_ROW + kb * 2 + hh * 16;
#pragma unroll
            for (int ks = 0; ks < 2; ++ks) {
                const bf16x8 pb = pack8(sc, 8 * ks);
                const bf16x8 v0 = *(const LAS bf16x8*)(vb + ks * 32), v1 = *(const LAS bf16x8*)(vb + 32 * SV_ROW + ks * 32);
                o0 = MFMA32(v0, pb, o0); o1 = MFMA32(v1, pb, o1);
            }
        }
        l = xhalf_sum(l);
        const float inv = 1.0f / l;
        bf16_t* orow = OA + (rowbase + Q0 + q0w + r) * 512 + head * 64;
        store_ot(orow, o0, 0, hh, inv); store_ot(orow, o1, 32, hh, inv);
    }
}

#define XB_TMO      128
#define XB_XCNT(j)  (256  + 64 * (j))
#define XB_XSUB(j)  (1280 + 64 * (j))
#define XB_XGEN(j)  (2304 + 64 * (j))
#define XB_TOP      3328
#define XB_TOPGEN   3392
#define XCD_BAR_WORDS 3456
#define XB_SPIN_CAP (1u << 18)

__device__ __forceinline__ unsigned xb_ld(unsigned* p)              { return __hip_atomic_load(p, __ATOMIC_RELAXED, __HIP_MEMORY_SCOPE_AGENT); }
__device__ __forceinline__ unsigned xb_add(unsigned* p, unsigned v) { return __hip_atomic_fetch_add(p, v, __ATOMIC_RELAXED, __HIP_MEMORY_SCOPE_AGENT); }
__device__ __forceinline__ unsigned xb_xcc_id() { return (unsigned)__builtin_amdgcn_s_getreg((3 << 11) | 20) & 0xFu; }
#define XB_SPIN(cond, bar) do { unsigned _sp = 0; while (cond) { __builtin_amdgcn_s_sleep(1); \
    if ((++_sp & 255u) == 0u) { if (xb_ld(&(bar)[XB_TMO])) break; if (_sp > XB_SPIN_CAP) { atomicAdd(&(bar)[XB_TMO], 1u); break; } } } } while (0)

struct XcdBarrier {
    unsigned* bar; unsigned x;
    volatile LAS unsigned* st;
};

__device__ __forceinline__ XcdBarrier xcd_barrier_post(unsigned* bar, volatile LAS unsigned* st) {
    XcdBarrier b; b.bar = bar; b.x = xb_xcc_id(); b.st = st;
    if (threadIdx.x == 0) (void)xb_add(&bar[XB_XCNT(b.x)], 1u);
    return b;
}
__device__ __forceinline__ void xcd_barrier_complete(unsigned* bar, unsigned x, unsigned& nloc, unsigned& nx) {
    const unsigned G = gridDim.x * gridDim.y * gridDim.z;
    unsigned sum, cnt, mine, sp = 0u;
    for (;;) {
        sum = 0u; cnt = 0u; mine = 0u;
#pragma unroll
        for (unsigned j = 0; j < 16; ++j) { const unsigned c = xb_ld(&bar[XB_XCNT(j)]); sum += c; cnt += (c > 0u) ? 1u : 0u; mine = (j == x) ? c : mine; }
        if (sum == G) break;
        __builtin_amdgcn_s_sleep(1);
        if ((++sp & 255u) == 0u) { if (xb_ld(&bar[XB_TMO])) break; if (sp > XB_SPIN_CAP) { atomicAdd(&bar[XB_TMO], 1u); break; } }
    }
    nloc = mine > 0u ? mine : 1u; nx = cnt > 0u ? cnt : 1u;
}

__device__ __forceinline__ void xcd_barrier(const XcdBarrier& b, const bool t0) {
    asm volatile("s_waitcnt vmcnt(0)" ::: "memory");
    __syncthreads();
    if (t0) {
        unsigned* bar = b.bar;
        __builtin_amdgcn_s_waitcnt(0);
        unsigned nloc = b.st[0], nx = b.st[1];
        if (nloc == 0u) { xcd_barrier_complete(bar, b.x, nloc, nx); b.st[0] = nloc; b.st[1] = nx; }
        const unsigned old = xb_add(&bar[XB_XSUB(b.x)], 1u);
        const unsigned gen = old / nloc;
        if (old + 1u == (gen + 1u) * nloc) {
            __builtin_amdgcn_fence(__ATOMIC_RELEASE, "agent");
            asm volatile("s_waitcnt vmcnt(0)" ::: "memory");
            const unsigned og = xb_add(&bar[XB_TOP], 1u);
            const unsigned tg = og / nx;
            if (og + 1u == (tg + 1u) * nx) xb_add(&bar[XB_TOPGEN], 1u);
            else XB_SPIN(xb_ld(&bar[XB_TOPGEN]) == tg, bar);
            __builtin_amdgcn_fence(__ATOMIC_ACQUIRE, "agent");
            xb_add(&bar[XB_XGEN(b.x)], 1u);
            asm volatile("s_waitcnt vmcnt(0)" ::: "memory");
        } else {
            XB_SPIN(xb_ld(&bar[XB_XGEN(b.x)]) == gen, bar);
            __builtin_amdgcn_fence(__ATOMIC_ACQUIRE, "agent");
            asm volatile("s_waitcnt vmcnt(0)" ::: "memory");
        }
    }
    __syncthreads();
}

template <class E> __device__ __forceinline__ void run_gemm(LAS unsigned char* lds, const bf16_t* A, const bf16_t* Bt, int lda, int Mrows, int N, int K, const E& e, int wv, int flip = 0) {
    pg8::Gemm g{A, Bt, Mrows, N, K, lda}; pg8::StaticOrder S; S.init(Mrows, N, (int)gridDim.x, (int)blockIdx.x); S.flip = flip;
    pg8::gemm_phase<E, pg8::StaticOrder, true, true>(lds, g, S, e, wv);
}

__global__ void __launch_bounds__(512) fwd_megakernel(Params p) {
    extern __shared__ __attribute__((aligned(16))) unsigned char lds_raw[];
    LAS unsigned char* lds = (LAS unsigned char*)lds_raw;
    cg::grid_group grid = cg::this_grid();
    if (threadIdx.x < 16) ((LAS unsigned*)(lds + 131072))[threadIdx.x] = 0u;
    __syncthreads();
    const XcdBarrier xbar = xcd_barrier_post((unsigned*)(p.ws + WS_CTL + WS_BAR), (volatile LAS unsigned*)(lds + 131072));
    const int wave = __builtin_amdgcn_readfirstlane(threadIdx.x >> 6);
#define FRESH_LANE() int tid = wave * 64 + hw_lane_id(); asm volatile("" : "+v"(tid)); const int lane = tid & 63
    const int G = gridDim.x, bx = blockIdx.x;
    const int vcu = (G % 8 == 0) ? (bx % 8) * (G / 8) + bx / 8 : bx;
    const int gw = vcu * 8 + wave, ngw = G * 8;
#define GAS __attribute__((address_space(1)))
#define FRESH(w) unsigned char* w; { GAS unsigned char* g_ = (GAS unsigned char*)p.ws; asm volatile("" : "+s"(g_)); w = (unsigned char*)g_; }
#define BIGP(w, off) ((bf16_t*)((w) + WS_BIG + (off)))

    {
        LAS unsigned* scr = (LAS unsigned*)lds;
        FRESH(ws); FRESH_LANE();
#pragma unroll 1
        for (int l = 0; l < DEPTH; ++l) {
            unsigned char* wl = ws + WS_W + (size_t)l * W_LAYER;
            const float* w_in = p.in[4] + (size_t)l * DM * D_IN;
            transpose_matrix(w_in, D_IN, DM, N1, 1, p.in[3] + l * DM, (bf16_t*)(wl + WO_IN1), scr, tid, vcu, G);
            transpose_matrix(w_in, D_IN, DM, NGATE, 2, p.in[3] + l * DM, (bf16_t*)(wl + WO_G), scr, tid, vcu, G);
            transpose_matrix(p.in[8] + (size_t)l * QL * NQB, NQB, QL, NQB, 0, p.in[6] + l * QL, (bf16_t*)(wl + WO_UQ), scr, tid, vcu, G);
            transpose_matrix(p.in[9] + (size_t)l * KVL * NKVB, NKVB, KVL, NKVB, 0, p.in[7] + l * KVL, (bf16_t*)(wl + WO_UKV), scr, tid, vcu, G);
            transpose_matrix(p.in[10] + (size_t)l * 512 * DM, DM, 512, DM, 0, nullptr, (bf16_t*)(wl + WO_A), scr, tid, vcu, G);
            transpose_matrix(p.in[11] + (size_t)l * 512 * DM, DM, 512, DM, 0, nullptr, (bf16_t*)(wl + WO_B), scr, tid, vcu, G);
            transpose_matrix(p.in[12] + (size_t)l * DM * DM, DM, DM, DM, 0, nullptr, (bf16_t*)(wl + WO_OUT), scr, tid, vcu, G);
            transpose_matrix(p.in[14] + (size_t)l * DM * DFF, DFF, DM, DFF, 0, p.in[13] + l * DM, (bf16_t*)(wl + WO_FF1), scr, tid, vcu, G);
            transpose_matrix(p.in[15] + (size_t)l * DFF * DM, DM, DFF, DM, 0, nullptr, (bf16_t*)(wl + WO_FF2), scr, tid, vcu, G);
        }
        if (bx == 0) {
            for (int t = tid; t < 1024; t += 512) {
                const int h = t >> 7, dist = t & 127; int bucket = dist;
                if (dist >= 16) { int lg = 16 + (int)(logf((float)dist / 16.0f) / 2.0794415416798357f * 16.0f); bucket = lg < 31 ? lg : 31; }
                ((float*)(ws + WS_CTL))[t] = p.in[2][bucket * 8 + h] * LOG2E;
            }
        }
        __syncthreads();
        for (int row = gw; row < MTOK; row += 2 * ngw)
            prologue_rows2(p.in[0], (const int*)p.in[1], (bf16_t*)(ws + WS_H), (float*)(ws + WS_SS), (float*)(ws + WS_CS), row, (row + ngw < MTOK) ? row + ngw : row, lane);
    }
    grid.sync();

#pragma unroll 1
    for (int l = 0; l < DEPTH; ++l) {
        const size_t wl = WS_W + (size_t)l * W_LAYER;
        Epi e{};
        { FRESH(ws); e = Epi{}; e.mode = EP_Z1; e.O = BIGP(ws, B_Z1); e.ldc = N1; e.O2 = BIGP(ws, B_VTA); e.O3 = BIGP(ws, B_KB); e.cs = (const float*)(ws + WS_CS);
          e.rs = (const float*)(ws + WS_SS); e.rs_ld = 16; e.rs_off = 0; e.rs_n = 16; e.rs_inv = 1.f / DM; e.ss_out = (float*)(ws + WS_SSL);
          run_gemm(lds, (const bf16_t*)(ws + WS_H), (const bf16_t*)(ws + wl + WO_IN1), DM, MTOK, N1, DM, e, wave, 1); }
        xcd_barrier(xbar, wave == 0 && hw_lane_id() == 0);
        { FRESH(ws); e = Epi{}; e.mode = EP_QB; e.O = BIGP(ws, B_QB); e.ldc = NQB; e.cs = (const float*)(ws + WS_CS);
          e.rs = (const float*)(ws + WS_SSL); e.rs_ld = 32; e.rs_off = 0; e.rs_n = 12; e.rs_inv = 1.f / QL;
          run_gemm(lds, BIGP(ws, B_Z1) + 768, (const bf16_t*)(ws + wl + WO_UQ), N1, MTOK, NQB, QL, e, wave); }
        { FRESH(ws); e = Epi{}; e.mode = EP_KVB; e.O2 = BIGP(ws, B_KB); e.O3 = BIGP(ws, B_VT);
          e.rs = (const float*)(ws + WS_SSL); e.rs_ld = 32; e.rs_off = 12; e.rs_n = 8; e.rs_inv = 1.f / KVL;
          run_gemm(lds, BIGP(ws, B_Z1) + 1152, (const bf16_t*)(ws + wl + WO_UKV), N1, MTOK, NKVB, KVL, e, wave); }
        xcd_barrier(xbar, wave == 0 && hw_lane_id() == 0);
        { FRESH(ws);
#pragma unroll 1
          for (int it = vcu; it < 512; it += G) {
            const int itl = (it & 31) + 32 * (it >> 8), bh = (G == 256) ? ((it >> 5) & 7) * 8 + (itl >> 3) : (it >> 3), pr = (G == 256) ? (itl & 7) : (it & 7);
#pragma unroll 1
            for (int k = 0; k < 2; ++k) mla_unit2(lds, BIGP(ws, B_QB), BIGP(ws, B_KB), BIGP(ws, B_VT), BIGP(ws, B_OB), bh >> 3, bh & 7, k ? pr : 15 - pr, wave);
          } }
        { FRESH(ws);
#pragma unroll 1
          for (int it = vcu; it < 1024; it += G) {
            const int itl = (it & 31) + 32 * (it >> 8), bk = (G == 256) ? ((it >> 5) & 7) * 2 + (itl >> 6) : (it >> 6), qblk = (G == 256) ? (itl & 63) : (it & 63);
            swa_unit(lds, BIGP(ws, B_Z1), BIGP(ws, B_VTA), (const float*)(ws + WS_CTL), p.in[5] + l * 8, BIGP(ws, B_OA), bk >> 1, bk & 1, qblk, wave);
          } }
        xcd_barrier(xbar, wave == 0 && hw_lane_id() == 0);
        { FRESH(ws); e = Epi{}; e.mode = EP_PLAIN; e.O = BIGP(ws, B_YA); e.ldc = DM;
          run_gemm(lds, BIGP(ws, B_OA), (const bf16_t*)(ws + wl + WO_A), 512, MTOK, DM, 512, e, wave); }
        { FRESH(ws); e = Epi{}; e.mode = EP_PLAIN; e.O = BIGP(ws, B_YB); e.ldc = DM;
          run_gemm(lds, BIGP(ws, B_OB), (const bf16_t*)(ws + wl + WO_B), 512, MTOK, DM, 512, e, wave); }
        xcd_barrier(xbar, wave == 0 && hw_lane_id() == 0);
        { FRESH(ws); e = Epi{}; e.mode = EP_GATE; e.O = BIGP(ws, B_MERGED); e.Y1 = BIGP(ws, B_YA); e.Y2 = BIGP(ws, B_YB);
          e.rs = (const float*)(ws + WS_SS); e.rs_ld = 16; e.rs_off = 0; e.rs_n = 16; e.rs_inv = 1.f / DM;
          run_gemm(lds, (const bf16_t*)(ws + WS_H), (const bf16_t*)(ws + wl + WO_G), DM, MTOK, NGATE, DM, e, wave, 1); }
        xcd_barrier(xbar, wave == 0 && hw_lane_id() == 0);
        { FRESH(ws); e = Epi{}; e.mode = EP_RESID; e.xb = (bf16_t*)(ws + WS_H); e.ss_out = (float*)(ws + WS_SS);
          run_gemm(lds, BIGP(ws, B_MERGED), (const bf16_t*)(ws + wl + WO_OUT), DM, MTOK, DM, DM, e, wave); }
        xcd_barrier(xbar, wave == 0 && hw_lane_id() == 0);
        { FRESH(ws); e = Epi{}; e.mode = EP_RELU2; e.O = BIGP(ws, B_HID); e.ldc = DFF;
          e.rs = (const float*)(ws + WS_SS); e.rs_ld = 16; e.rs_off = 0; e.rs_n = 16; e.rs_inv = 1.f / DM;
          run_gemm(lds, (const bf16_t*)(ws + WS_H), (const bf16_t*)(ws + wl + WO_FF1), DM, MTOK, DFF, DM, e, wave, 1); }
        xcd_barrier(xbar, wave == 0 && hw_lane_id() == 0);
        { FRESH(ws); e = Epi{}; e.mode = EP_RESID; e.xb = (bf16_t*)(ws + WS_H); e.ss_out = (float*)(ws + WS_SS);
          run_gemm(lds, BIGP(ws, B_HID), (const bf16_t*)(ws + wl + WO_FF2), DFF, MTOK, DM, DFF, e, wave, 0); }
        xcd_barrier(xbar, wave == 0 && hw_lane_id() == 0);
    }
    { FRESH(ws); FRESH_LANE();
      for (int row = gw; row < MTOK; row += 2 * ngw) final_rows2((const bf16_t*)(ws + WS_H), (const float*)(ws + WS_SS), p.in[16], p.out, row, (row + ngw < MTOK) ? row + ngw : row, lane); }
}

extern "C" void kernel_launch(void* const* d_in, const int* in_sizes, int n_in, void* d_out, int out_size, void* d_ws, size_t ws_size, hipStream_t stream) {
    static int grid_blocks = 0;
    if (grid_blocks == 0) {
        if (n_in != 17 || out_size != MTOK * DM || ws_size < WS_END) { fprintf(stderr, "kernel_launch: unexpected shapes (n_in %d out %d ws %zu, need %zu)\n", n_in, out_size, ws_size, (size_t)WS_END); grid_blocks = -1; return; }
        int dev = 0, cus = 0, per_cu = 0;
        hipGetDevice(&dev);
        hipDeviceGetAttribute(&cus, hipDeviceAttributeMultiprocessorCount, dev);
        if (hipFuncSetAttribute((const void*)fwd_megakernel, hipFuncAttributeMaxDynamicSharedMemorySize, LDS_BYTES) != hipSuccess) { fprintf(stderr, "kernel_launch: hipFuncSetAttribute failed\n"); grid_blocks = -1; return; }
        if (hipOccupancyMaxActiveBlocksPerMultiprocessor(&per_cu, (const void*)fwd_megakernel, 512, LDS_BYTES) != hipSuccess || per_cu < 1) { fprintf(stderr, "kernel_launch: occupancy query gave %d\n", per_cu); per_cu = 1; }
        (void)hipGetLastError();
        grid_blocks = cus;
    }
    if (grid_blocks < 0) return;
    if (hipMemsetAsync((char*)d_ws + WS_CTL + WS_BAR, 0, XCD_BAR_WORDS * 4, stream) != hipSuccess) { fprintf(stderr, "kernel_launch: memset failed\n"); return; }
    Params p{};
    for (int i = 0; i < 17; ++i) p.in[i] = (const float*)d_in[i];
    p.out = (float*)d_out; p.ws = (unsigned char*)d_ws;
    void* args[] = {&p};
    hipError_t e = hipLaunchCooperativeKernel((const void*)fwd_megakernel, dim3(grid_blocks), dim3(512), args, LDS_BYTES, stream);
    if (e != hipSuccess) fprintf(stderr, "cooperative launch failed: %s (grid %d)\n", hipGetErrorString(e), grid_blocks);
}
```
